# Optimizing an MI355X kernel written in HIP

```python
import jax, jax.numpy as jnp
from jax import lax
import numpy as np

D_MODEL = 1024
BATCH = 16
SEQ = 2048
DEPTH = 4

N_CONV_LAYERS = DEPTH // 2
N_MLA_LAYERS = DEPTH - N_CONV_LAYERS
CONV_WIDTH = 3
V_HEAD_DIM = 128
N_HEADS = D_MODEL // V_HEAD_DIM
QK_NOPE_DIM = 128
QK_ROPE_DIM = 64
KV_LORA_RANK = D_MODEL // 4
Q_LORA_RANK = 3 * D_MODEL // 8
D_FF = -(-8 * D_MODEL // (3 * 256)) * 256
ROPE_THETA = 10000.0
RMS_EPS = 1e-6
Q_BLOCK = 128

kernel_name = "yoco_shortconv_mla_hybrid"


def rms_norm(x, g):
    xf = x.astype(jnp.float32)
    y = xf * lax.rsqrt(jnp.mean(xf * xf, axis=-1, keepdims=True) + RMS_EPS)
    return (y * g.astype(jnp.float32)).astype(x.dtype)


def rope_tables(positions):
    inv_freq = ROPE_THETA ** (-jnp.arange(0, QK_ROPE_DIM, 2, dtype=jnp.float32) / QK_ROPE_DIM)
    ang = positions.astype(jnp.float32)[..., None] * inv_freq
    return jnp.cos(ang), jnp.sin(ang)


def apply_rope(x, cos, sin):
    cos = cos.astype(x.dtype)
    sin = sin.astype(x.dtype)
    x1, x2 = jnp.split(x, 2, axis=-1)
    return jnp.concatenate([x1 * cos - x2 * sin, x1 * sin + x2 * cos], axis=-1)


def short_conv_mixer(h, w_in, conv_w, w_out):
    s = h.shape[1]
    u = h @ w_in
    gate_b, gate_c, val = jnp.split(u, 3, axis=-1)
    z = gate_c * val
    zp = jnp.pad(z, ((0, 0), (CONV_WIDTH - 1, 0), (0, 0)))
    conv = sum(conv_w[k] * zp[:, k:k + s] for k in range(CONV_WIDTH))
    return (gate_b * conv) @ w_out


def swiglu_ffn(h, w13, w2):
    g, u = jnp.split(h @ w13, 2, axis=-1)
    return (jax.nn.silu(g) * u) @ w2


def shared_mla_kv(h, kv_norm_g, w_dkv, kv_latent_norm_g, w_ukv, cos, sin):
    b, s, _ = h.shape
    hn = rms_norm(h, kv_norm_g)
    ckv = hn @ w_dkv
    c_lat = rms_norm(ckv[..., :KV_LORA_RANK], kv_latent_norm_g)
    k_pe = apply_rope(ckv[..., KV_LORA_RANK:], cos, sin)
    kv = (c_lat @ w_ukv).reshape(b, s, N_HEADS, QK_NOPE_DIM + V_HEAD_DIM)
    k_nope, v = kv[..., :QK_NOPE_DIM], kv[..., QK_NOPE_DIM:]
    return k_nope, k_pe, v


def causal_block_attention(q_nope, q_pe, k_nope, k_pe, v):
    b, s = q_nope.shape[:2]
    nb = s // Q_BLOCK
    qn = q_nope.reshape(b, nb, Q_BLOCK, N_HEADS, QK_NOPE_DIM).transpose(1, 0, 2, 3, 4)
    qr = q_pe.reshape(b, nb, Q_BLOCK, N_HEADS, QK_ROPE_DIM).transpose(1, 0, 2, 3, 4)
    starts = jnp.arange(nb, dtype=jnp.int32) * Q_BLOCK
    k_idx = jnp.arange(s, dtype=jnp.int32)
    scale = (QK_NOPE_DIM + QK_ROPE_DIM) ** -0.5
    neg = jnp.finfo(jnp.float32).min

    def one_block(args):
        qn_b, qr_b, start = args
        sc = (jnp.einsum('bqhd,bkhd->bhqk', qn_b, k_nope)
              + jnp.einsum('bqhr,bkr->bhqk', qr_b, k_pe))
        sc = sc.astype(jnp.float32) * scale
        q_idx = start + jnp.arange(Q_BLOCK, dtype=jnp.int32)
        mask = k_idx[None, :] <= q_idx[:, None]
        p = jax.nn.softmax(jnp.where(mask, sc, neg), axis=-1).astype(v.dtype)
        return jnp.einsum('bhqk,bkhd->bqhd', p, v)

    out = lax.map(one_block, (qn, qr, starts))
    return out.transpose(1, 0, 2, 3, 4).reshape(b, s, N_HEADS, V_HEAD_DIM)


def mla_mixer(h, w_dq, q_norm_g, w_uq, w_o, k_nope, k_pe, v, cos_h, sin_h):
    b, s, _ = h.shape
    cq = rms_norm(h @ w_dq, q_norm_g)
    q = (cq @ w_uq).reshape(b, s, N_HEADS, QK_NOPE_DIM + QK_ROPE_DIM)
    q_nope = q[..., :QK_NOPE_DIM]
    q_pe = apply_rope(q[..., QK_NOPE_DIM:], cos_h, sin_h)
    attn = causal_block_attention(q_nope, q_pe, k_nope, k_pe, v)
    return attn.reshape(b, s, N_HEADS * V_HEAD_DIM) @ w_o


def setup_inputs(seed: int = 0) -> dict:
    key = jax.random.key(seed)
    ks = iter(jax.random.split(key, 32))
    f32 = jnp.float32
    res_scale = (2 * DEPTH) ** -0.5

    def w(shape, fan_in, extra=1.0):
        return jax.random.normal(next(ks), shape, f32) * (fan_in ** -0.5) * extra

    def gain(shape):
        return 1.0 + 0.02 * jax.random.normal(next(ks), shape, f32)

    na, nm = N_CONV_LAYERS, N_MLA_LAYERS
    x = jax.random.normal(next(ks), (BATCH, SEQ, D_MODEL), f32)
    positions = jnp.broadcast_to(jnp.arange(SEQ, dtype=jnp.int32), (BATCH, SEQ))
    return {
        "x": x,
        "positions": positions,
        "conv_norm_g": gain((na, D_MODEL)),
        "conv_w_in": w((na, D_MODEL, 3 * D_MODEL), D_MODEL),
        "conv_w": w((na, CONV_WIDTH, D_MODEL), CONV_WIDTH),
        "conv_w_out": w((na, D_MODEL, D_MODEL), D_MODEL, res_scale),
        "conv_ffn_norm_g": gain((na, D_MODEL)),
        "conv_ffn_w13": w((na, D_MODEL, 2 * D_FF), D_MODEL),
        "conv_ffn_w2": w((na, D_FF, D_MODEL), D_FF, res_scale),
        "kv_norm_g": gain((D_MODEL,)),
        "w_dkv": w((D_MODEL, KV_LORA_RANK + QK_ROPE_DIM), D_MODEL),
        "kv_latent_norm_g": gain((KV_LORA_RANK,)),
        "w_ukv": w((KV_LORA_RANK, N_HEADS * (QK_NOPE_DIM + V_HEAD_DIM)), KV_LORA_RANK),
        "mla_norm_g": gain((nm, D_MODEL)),
        "mla_w_dq": w((nm, D_MODEL, Q_LORA_RANK), D_MODEL),
        "mla_q_norm_g": gain((nm, Q_LORA_RANK)),
        "mla_w_uq": w((nm, Q_LORA_RANK, N_HEADS * (QK_NOPE_DIM + QK_ROPE_DIM)), Q_LORA_RANK),
        "mla_w_o": w((nm, N_HEADS * V_HEAD_DIM, D_MODEL), N_HEADS * V_HEAD_DIM, res_scale),
        "mla_ffn_norm_g": gain((nm, D_MODEL)),
        "mla_ffn_w13": w((nm, D_MODEL, 2 * D_FF), D_MODEL),
        "mla_ffn_w2": w((nm, D_FF, D_MODEL), D_FF, res_scale),
        "final_norm_g": gain((D_MODEL,)),
    }


def reference(x, positions,
              conv_norm_g, conv_w_in, conv_w, conv_w_out,
              conv_ffn_norm_g, conv_ffn_w13, conv_ffn_w2,
              kv_norm_g, w_dkv, kv_latent_norm_g, w_ukv,
              mla_norm_g, mla_w_dq, mla_q_norm_g, mla_w_uq, mla_w_o,
              mla_ffn_norm_g, mla_ffn_w13, mla_ffn_w2,
              final_norm_g):
    cos, sin = rope_tables(positions)
    cos_h, sin_h = cos[:, :, None, :], sin[:, :, None, :]
    h = x
    k_nope = k_pe = v = None
    for i in range(DEPTH):
        if i < N_CONV_LAYERS:
            h = h + short_conv_mixer(rms_norm(h, conv_norm_g[i]), conv_w_in[i], conv_w[i], conv_w_out[i])
            h = h + swiglu_ffn(rms_norm(h, conv_ffn_norm_g[i]), conv_ffn_w13[i], conv_ffn_w2[i])
        else:
            if i == N_CONV_LAYERS:
                k_nope, k_pe, v = shared_mla_kv(h, kv_norm_g, w_dkv, kv_latent_norm_g, w_ukv, cos, sin)
            j = i - N_CONV_LAYERS
            h = h + mla_mixer(rms_norm(h, mla_norm_g[j]), mla_w_dq[j], mla_q_norm_g[j], mla_w_uq[j],
                              mla_w_o[j], k_nope, k_pe, v, cos_h, sin_h)
            h = h + swiglu_ffn(rms_norm(h, mla_ffn_norm_g[j]), mla_ffn_w13[j], mla_ffn_w2[j])
    return rms_norm(h, final_norm_g)
```

```cpp
#include <hip/hip_runtime.h>
#include <hip/hip_cooperative_groups.h>
#include <cstdio>
#include <cstdint>
namespace cg = cooperative_groups;

constexpr int T_ = 32768, DM = 1024, SEQ = 2048, NBATCH = 16, NHEAD = 8, DFF = 2816;
constexpr float RMS_EPS = 1e-6f;
constexpr float QSCALE = 0.07216878364870322f * 1.4426950408889634f;

namespace pg8 {
#define PG8_LAS __attribute__((address_space(3)))
typedef unsigned short bf16_t;
typedef short bf16x8 __attribute__((ext_vector_type(8)));
typedef float f32x4 __attribute__((ext_vector_type(4)));
typedef unsigned u32x4 __attribute__((ext_vector_type(4)));
constexpr int BM = 256, BK = 64, HALF = 128, HTB = HALF * BK * 2  , STAGE_BYTES = 8 * HTB, NXCD = 8, WGM = 8;

__host__ __device__ __forceinline__ int lds_byte(int r, int c) { const int st = (r >> 4) * 2 + (c >> 5), rr = r & 15, cc = c & 31, ob = rr * 64 + cc * 2; return st * 1024 + (ob ^ (((ob >> 9) & 1) << 5)); }
__host__ __device__ __forceinline__ void stage_rc(int b, int& R, int& C) { const int st = b / 1024, sb = b % 1024, swz = sb ^ (((sb >> 9) & 1) << 5); R = (st >> 1) * 16 + swz / 64; C = (st & 1) * 32 + (swz % 64) / 2; }
__host__ __device__ __forceinline__ int perm32(int rho) { const int n = rho >> 4, i = rho & 15; return 8 * (i >> 2) + 4 * n + (i & 3); }

struct Unit { int pm, pn; };
struct Gemm { const bf16_t* A; const bf16_t* Bt; int M, N, K; };

struct StaticOrder {
    int nM, nN, nwg, G, c;
    __host__ __device__ void init(int M, int N, int G_, int c_) { nM = M / BM; nN = N / BM; nwg = nM * nN; G = G_; c = c_; }
    __host__ __device__ bool next(int i, Unit& u) const {
        const long L = (long)i * G + c; if (L >= nwg) return false;
        int wgid = (int)L; { const int q = nwg / NXCD, r = nwg % NXCD, xcd = wgid % NXCD, off = wgid / NXCD; wgid = (xcd < r ? xcd * (q + 1) : r * (q + 1) + (xcd - r) * q) + off; }
        const int nig = WGM * nN, gid = wgid / nig, fm = gid * WGM, gsz = (nM - fm) < WGM ? (nM - fm) : WGM;
        u.pm = fm + ((wgid % nig) % gsz); u.pn = (wgid % nig) / gsz; return true;
    }
    __device__ __forceinline__ void a_ready(const Unit&) const {}
    __device__ __forceinline__ void done(const Unit&) const {}
};
typedef float f32x2_t __attribute__((ext_vector_type(2))); typedef __bf16 bf16x2_t __attribute__((ext_vector_type(2)));
typedef unsigned u32x2 __attribute__((ext_vector_type(2)));
__device__ __forceinline__ unsigned pk_bf16(float lo, float hi) { f32x2_t v = {lo, hi}; bf16x2_t b = __builtin_convertvector(v, bf16x2_t); return __builtin_bit_cast(unsigned, b); }
__device__ __forceinline__ u32x4 pk8(const f32x4 a, const f32x4 b) { u32x4 w; w.x = pk_bf16(a[0], a[1]); w.y = pk_bf16(a[2], a[3]); w.z = pk_bf16(b[0], b[1]); w.w = pk_bf16(b[2], b[3]); return w; }
__device__ __forceinline__ float dot4(const f32x4 a) { return (a[0] * a[0] + a[1] * a[1]) + (a[2] * a[2] + a[3] * a[3]); }
template <int NS> __device__ __forceinline__ float rstd_of(const float* part, int row, float invn) {
    float s = 0.f;
#pragma unroll
    for (int i = 0; i < NS / 4; ++i) { const f32x4 v = *(const f32x4*)(part + (size_t)row * NS + 4 * i); s += (v[0] + v[1]) + (v[2] + v[3]); }
    return __builtin_amdgcn_rsqf(s * invn + 1e-6f);
}
typedef const f32x4 (&AccRef)[2][2][4][2];
template <int NS> __device__ __forceinline__ void wave_rstd(const float* part, int pm, int wr, int lane, float invn, float (&r)[2][4]) {
    constexpr int QPR = NS / 4, RPL = 64 / QPR, NL = 128 / RPL;
    asm volatile("" : "+v"(lane));
    float t[NL];
#pragma unroll
    for (int i = 0; i < NL; ++i) { const int rl = lane / QPR + RPL * i, grow = pm * BM + HALF * (rl >> 6) + 64 * wr + (rl & 63);
        const f32x4 v = *(const f32x4*)(part + (size_t)grow * NS + 4 * (lane % QPR)); float sm = (v[0] + v[1]) + (v[2] + v[3]);
#pragma unroll
        for (int o = 1; o < QPR; o <<= 1) sm += __shfl_xor(sm, o);
        t[i] = __builtin_amdgcn_rsqf(sm * invn + 1e-6f); }
    const int fr = lane & 15;
#pragma unroll
    for (int ai = 0; ai < 2; ++ai)
#pragma unroll
        for (int m = 0; m < 4; ++m) { const int rl0 = 64 * ai + 16 * m; r[ai][m] = __shfl(t[rl0 / RPL], ((rl0 % RPL) + fr) * QPR); }
}


struct EpiConvIn {
    static constexpr bool PERM = true, AFTER_DRAIN = false;
    const float* ssq; bf16_t* Z; bf16_t* GB;
    __device__ __forceinline__ void operator()(AccRef acc, const Unit& u, int wr, int wc, int fr, int fq) const {
        const int row0 = u.pm * BM + wr * 64 + fr; float rs[2][4]; wave_rstd<16>(ssq, u.pm, wr, fq * 16 + fr, 1.0f / 1024.0f, rs);
#pragma unroll
        for (int ai = 0; ai < 2; ++ai)
#pragma unroll
            for (int m = 0; m < 4; ++m) { const int row = row0 + ai * HALF + m * 16; const float r = rs[ai][m];
                if (u.pn < 8) { const float r2 = r * r; const f32x4 z0 = acc[ai][0][m][0] * acc[ai][1][m][0] * r2, z1 = acc[ai][0][m][1] * acc[ai][1][m][1] * r2;
                    *(u32x4*)(Z + (size_t)row * 1024 + u.pn * 128 + wc * 32 + 8 * fq) = pk8(z0, z1); }
                else {
#pragma unroll
                    for (int bj = 0; bj < 2; ++bj) *(u32x4*)(GB + (size_t)row * 1024 + (u.pn - 8) * 256 + bj * HALF + wc * 32 + 8 * fq) = pk8(acc[ai][bj][m][0] * r, acc[ai][bj][m][1] * r); } }
    }
};
struct TripleOrder {
    int G, c;
    __host__ __device__ void init(int G_, int c_) { G = G_; c = c_; }
    __host__ __device__ bool next(int i, Unit& u) const {
        const int tr = i / 3, j = i - 3 * tr, tidx = tr * G + c; if (tidx >= 512) return false;
        const int w = (tidx & 7) * 64 + (tidx >> 3);
        u.pm = w >> 2; const int q = w & 3; u.pn = (j == 2) ? 8 + q : 2 * q + j; return true;
    }
    __device__ __forceinline__ void a_ready(const Unit&) const {}
    __device__ __forceinline__ void done(const Unit&) const {}
};
__device__ __forceinline__ void unpack8(const u32x4 v, f32x4& a, f32x4& b) {
    a = (f32x4){__uint_as_float(v.x << 16), __uint_as_float(v.x & 0xffff0000u), __uint_as_float(v.y << 16), __uint_as_float(v.y & 0xffff0000u)};
    b = (f32x4){__uint_as_float(v.z << 16), __uint_as_float(v.z & 0xffff0000u), __uint_as_float(v.w << 16), __uint_as_float(v.w & 0xffff0000u)};
}
struct EpiConvFused {
    static constexpr bool PERM = true, AFTER_DRAIN = false;
    const float* ssq; bf16_t* Z; bf16_t* GB; bf16_t* Y; const float* cw; PG8_LAS float* rcache; int& cached_pm;
    __device__ __forceinline__ void operator()(AccRef acc, const Unit& u, int wr, int wc, int fr, int fq) const {
        const int row0 = u.pm * BM + wr * 64 + fr; PG8_LAS float* rc = rcache + (wr * 4 + wc) * 128 + fr;
        if (u.pm != cached_pm) { float t[2][4]; wave_rstd<16>(ssq, u.pm, wr, fq * 16 + fr, 1.0f / 1024.0f, t);
            if (fq == 0) {
#pragma unroll
                for (int ai = 0; ai < 2; ++ai)
#pragma unroll
                    for (int m = 0; m < 4; ++m) rc[ai * 64 + m * 16] = t[ai][m]; }
            cached_pm = u.pm; }
        if (u.pn < 8) {
            const int col = u.pn * 128 + wc * 32 + 8 * fq;
#pragma unroll
            for (int ai = 0; ai < 2; ++ai)
#pragma unroll
                for (int m = 0; m < 4; ++m) { const int row = row0 + ai * HALF + m * 16; const float r1 = rc[ai * 64 + m * 16], r2 = r1 * r1;
                    *(u32x4*)(Z + (size_t)row * 1024 + col) = pk8(acc[ai][0][m][0] * acc[ai][1][m][0] * r2, acc[ai][0][m][1] * acc[ai][1][m][1] * r2); }
        } else {
            const int q = u.pn - 8;
#pragma unroll
            for (int bj = 0; bj < 2; ++bj) { const int col = q * 256 + bj * HALF + wc * 32 + 8 * fq;
                const f32x4 w0a = *(const f32x4*)(cw + col), w0b = *(const f32x4*)(cw + col + 4), w1a = *(const f32x4*)(cw + 1024 + col), w1b = *(const f32x4*)(cw + 1024 + col + 4),
                            w2a = *(const f32x4*)(cw + 2048 + col), w2b = *(const f32x4*)(cw + 2048 + col + 4);
#pragma unroll
                for (int ai = 0; ai < 2; ++ai)
#pragma unroll
                    for (int mh = 0; mh < 2; ++mh) { u32x4 zq[2][3];
#pragma unroll
                        for (int mm = 0; mm < 2; ++mm) { const int row = row0 + ai * HALF + (2 * mh + mm) * 16; const unsigned bo = (unsigned)(row * 1024 + col) * 2u; const bool ok = (row & 255) >= 2;
                            zq[mm][0] = *(const u32x4*)((const char*)Z + bo); zq[mm][1] = *(const u32x4*)((const char*)Z + (ok ? bo - 2048u : bo)); zq[mm][2] = *(const u32x4*)((const char*)Z + (ok ? bo - 4096u : bo)); }
                        asm volatile("" ::: "memory");
#pragma unroll
                        for (int mm = 0; mm < 2; ++mm) { const int m = 2 * mh + mm, row = row0 + ai * HALF + m * 16; const float r = rc[ai * 64 + m * 16]; const unsigned bo = (unsigned)(row * 1024 + col) * 2u;
                            const f32x4 ga = acc[ai][bj][m][0] * r, gb = acc[ai][bj][m][1] * r;
                            if ((row & 255) < 2) *(u32x4*)((char*)GB + bo) = pk8(ga, gb);
                            else { f32x4 z0a, z0b, z1a, z1b, z2a, z2b; unpack8(zq[mm][0], z0a, z0b); unpack8(zq[mm][1], z1a, z1b); unpack8(zq[mm][2], z2a, z2b);
                                *(u32x4*)((char*)Y + bo) = pk8(ga * (w0a * z2a + w1a * z1a + w2a * z0a), gb * (w0b * z2b + w1b * z1b + w2b * z0b)); } } } }
        }
    }
};
template <bool F32BASE> struct EpiResid {
    static constexpr bool PERM = true, AFTER_DRAIN = false;
    const float* xbase; bf16_t* hb; float* ssq;
    __device__ __forceinline__ void operator()(AccRef acc, const Unit& u, int wr, int wc, int fr, int fq) const {
        const int row0 = u.pm * BM + wr * 64 + fr, col0 = u.pn * BM + wc * 32 + 8 * fq;
        if (F32BASE) {
#pragma unroll
            for (int ai = 0; ai < 2; ++ai)
#pragma unroll
                for (int mh = 0; mh < 2; ++mh) { f32x4 b[2][2][2];
#pragma unroll
                    for (int mm = 0; mm < 2; ++mm)
#pragma unroll
                        for (int bj = 0; bj < 2; ++bj) { const size_t off = (size_t)(row0 + ai * HALF + (2 * mh + mm) * 16) * 1024 + col0 + bj * HALF; b[mm][bj][0] = *(const f32x4*)(xbase + off); b[mm][bj][1] = *(const f32x4*)(xbase + off + 4); }
                    asm volatile("" ::: "memory");
#pragma unroll
                    for (int mm = 0; mm < 2; ++mm) { const int m = 2 * mh + mm, row = row0 + ai * HALF + m * 16; float s = 0.f;
#pragma unroll
                        for (int bj = 0; bj < 2; ++bj) { const size_t off = (size_t)row * 1024 + col0 + bj * HALF; const f32x4 o0 = b[mm][bj][0] + acc[ai][bj][m][0], o1 = b[mm][bj][1] + acc[ai][bj][m][1];
                            *(u32x4*)(hb + off) = pk8(o0, o1); s += dot4(o0) + dot4(o1); }
                        s += __shfl_xor(s, 16); s += __shfl_xor(s, 32);
                        if (fq == 0) ssq[(size_t)row * 16 + u.pn * 4 + wc] = s; } }
        } else {
#pragma unroll
            for (int ai = 0; ai < 2; ++ai) { u32x4 old[4][2];
#pragma unroll
                for (int m = 0; m < 4; ++m)
#pragma unroll
                    for (int bj = 0; bj < 2; ++bj) old[m][bj] = *(const u32x4*)(hb + (size_t)(row0 + ai * HALF + m * 16) * 1024 + col0 + bj * HALF);
                asm volatile("" ::: "memory");
#pragma unroll
                for (int m = 0; m < 4; ++m) { const int row = row0 + ai * HALF + m * 16; float s = 0.f;
#pragma unroll
                    for (int bj = 0; bj < 2; ++bj) { const size_t off = (size_t)row * 1024 + col0 + bj * HALF; f32x4 b0, b1; unpack8(old[m][bj], b0, b1);
                        const f32x4 o0 = b0 + acc[ai][bj][m][0], o1 = b1 + acc[ai][bj][m][1];
                        *(u32x4*)(hb + off) = pk8(o0, o1); s += dot4(o0) + dot4(o1); }
                    s += __shfl_xor(s, 16); s += __shfl_xor(s, 32);
                    if (fq == 0) ssq[(size_t)row * 16 + u.pn * 4 + wc] = s; } }
        }
    }
};
struct EpiSwiglu {
    static constexpr bool PERM = true, AFTER_DRAIN = false;
    const float* ssq; bf16_t* ACT; PG8_LAS float* rcache; int& cached_pm;
    __device__ __forceinline__ void operator()(AccRef acc, const Unit& u, int wr, int wc, int fr, int fq) const {
        const int row0 = u.pm * BM + wr * 64 + fr; PG8_LAS float* rc = rcache + (wr * 4 + wc) * 128 + fr;
        if (u.pm != cached_pm) { float t[2][4]; wave_rstd<16>(ssq, u.pm, wr, fq * 16 + fr, 1.0f / 1024.0f, t);
            if (fq == 0) {
#pragma unroll
                for (int ai = 0; ai < 2; ++ai)
#pragma unroll
                    for (int m = 0; m < 4; ++m) rc[ai * 64 + m * 16] = t[ai][m]; }
            cached_pm = u.pm; }
        float rs[2][4];
#pragma unroll
        for (int ai = 0; ai < 2; ++ai)
#pragma unroll
            for (int m = 0; m < 4; ++m) rs[ai][m] = rc[ai * 64 + m * 16];
#pragma unroll
        for (int ai = 0; ai < 2; ++ai)
#pragma unroll
            for (int m = 0; m < 4; ++m) { const int row = row0 + ai * HALF + m * 16; const float r = rs[ai][m], c = -1.4426950408889634f * r, ir2 = __builtin_amdgcn_rcpf(r * r); f32x4 a[2];
#pragma unroll
                for (int n = 0; n < 2; ++n) { const f32x4 x = acc[ai][0][m][n] * c, gu = acc[ai][0][m][n] * acc[ai][1][m][n];
#pragma unroll
                    for (int e = 0; e < 4; ++e) a[n][e] = gu[e] * __builtin_amdgcn_rcpf(__builtin_fmaf(__builtin_amdgcn_exp2f(x[e]), ir2, ir2)); }
                __builtin_nontemporal_store(pk8(a[0], a[1]), (u32x4*)((char*)ACT + (unsigned)((row * 2816 + u.pn * 128 + wc * 32 + 8 * fq) * 2))); }
    }
};
struct EpiDKVQ {
    static constexpr bool PERM = true, AFTER_DRAIN = false;
    const float* ssq; int pn_off; bf16_t* CLAT; float* ssql; bf16_t* KPE; const float* CS; bf16_t* CQ; float* ssqq;
    __device__ __forceinline__ void operator()(AccRef acc, const Unit& u, int wr, int wc, int fr, int fq) const {
        const int row0 = u.pm * BM + wr * 64 + fr, pn = u.pn + pn_off; float rs[2][4]; wave_rstd<16>(ssq, u.pm, wr, fq * 16 + fr, 1.0f / 1024.0f, rs);
#pragma unroll
        for (int ai = 0; ai < 2; ++ai)
#pragma unroll
            for (int m = 0; m < 4; ++m) { const int row = row0 + ai * HALF + m * 16; const float r = rs[ai][m];
                if (pn == 0) { float s = 0.f;
#pragma unroll
                    for (int bj = 0; bj < 2; ++bj) { const f32x4 a = acc[ai][bj][m][0] * r, b = acc[ai][bj][m][1] * r; s += dot4(a) + dot4(b);
                        *(u32x4*)(CLAT + (size_t)row * 256 + bj * HALF + wc * 32 + 8 * fq) = pk8(a, b); }
                    s += __shfl_xor(s, 16); s += __shfl_xor(s, 32);
                    if (fq == 0) ssql[(size_t)row * 4 + wc] = s;
                } else if (pn == 1) {
                    if (wc == 0) { f32x4 o1[2], o2[2];
#pragma unroll
                        for (int n = 0; n < 2; ++n) { const f32x4 x1 = acc[ai][0][m][n] * r, x2 = acc[ai][1][m][n] * r; const float* cs = CS + ((size_t)row * 32 + 8 * fq + 4 * n) * 2;
                            const f32x4 c01 = *(const f32x4*)cs, c23 = *(const f32x4*)(cs + 4);
                            const f32x4 co = {c01[0], c01[2], c23[0], c23[2]}, si = {c01[1], c01[3], c23[1], c23[3]};
                            o1[n] = x1 * co - x2 * si; o2[n] = x1 * si + x2 * co; }
                        *(u32x4*)(KPE + (size_t)row * 64 + 8 * fq) = pk8(o1[0], o1[1]); *(u32x4*)(KPE + (size_t)row * 64 + 32 + 8 * fq) = pk8(o2[0], o2[1]); }
                } else { const int t = pn - 2; float s = 0.f;
#pragma unroll
                    for (int bj = 0; bj < 2; ++bj) { const f32x4 a = acc[ai][bj][m][0] * r, b = acc[ai][bj][m][1] * r; s += dot4(a) + dot4(b);
                        if (t == 0 || bj == 0) *(u32x4*)(CQ + (size_t)row * 384 + t * 256 + bj * HALF + wc * 32 + 8 * fq) = pk8(a, b); }
                    s += __shfl_xor(s, 16); s += __shfl_xor(s, 32);
                    if (fq == 0) ssqq[(size_t)row * 8 + t * 4 + wc] = s; } }
    }
};
struct EpiRowScale {
    static constexpr bool PERM = true, AFTER_DRAIN = false;
    const float* ssql; bf16_t* O;
    __device__ __forceinline__ void operator()(AccRef acc, const Unit& u, int wr, int wc, int fr, int fq) const {
        const int row0 = u.pm * BM + wr * 64 + fr; float rr[2][4];
#pragma unroll
        for (int ai = 0; ai < 2; ++ai)
#pragma unroll
            for (int m = 0; m < 4; ++m) rr[ai][m] = rstd_of<4>(ssql, row0 + ai * HALF + m * 16, 1.0f / 256.0f);
        asm volatile("" ::: "memory");
#pragma unroll
        for (int ai = 0; ai < 2; ++ai)
#pragma unroll
            for (int m = 0; m < 4; ++m) { const int row = row0 + ai * HALF + m * 16; const float r = rr[ai][m];
#pragma unroll
                for (int bj = 0; bj < 2; ++bj) *(u32x4*)(O + (size_t)row * 1024 + u.pn * BM + bj * HALF + wc * 32 + 8 * fq) = pk8(acc[ai][bj][m][0] * r, acc[ai][bj][m][1] * r); }
    }
};
struct EpiVT {
    static constexpr bool PERM = true, AFTER_DRAIN = false;
    const float* ssql; bf16_t* VT;
    __device__ __forceinline__ void operator()(AccRef acc, const Unit& u, int wr, int wc, int fr, int fq) const {
        const int row0 = u.pm * BM + wr * 64 + fr;
#pragma unroll
        for (int bj = 0; bj < 2; ++bj) { const int c0 = u.pn * BM + bj * HALF + wc * 32 + 8 * fq; f32x4 r0, r1;
#pragma unroll
            for (int e = 0; e < 4; ++e) { r0[e] = rstd_of<4>(ssql, c0 + e, 1.0f / 256.0f); r1[e] = rstd_of<4>(ssql, c0 + 4 + e, 1.0f / 256.0f); }
            const int b = c0 >> 11, s = c0 & 2047;
#pragma unroll
            for (int ai = 0; ai < 2; ++ai)
#pragma unroll
                for (int m = 0; m < 4; ++m) { const int row = row0 + ai * HALF + m * 16;
                    *(u32x4*)(VT + ((size_t)b * 1024 + row) * 2048 + s) = pk8(acc[ai][bj][m][0] * r0, acc[ai][bj][m][1] * r1); } }
    }
};
struct EpiQ {
    static constexpr bool PERM = true, AFTER_DRAIN = false;
    const float* ssqq; const float* CS; bf16_t* Q; float qscale;
    __device__ __forceinline__ void operator()(AccRef acc, const Unit& u, int wr, int wc, int fr, int fq) const {
        const int row0 = u.pm * BM + wr * 64 + fr; float rs[2][4]; wave_rstd<8>(ssqq, u.pm, wr, fq * 16 + fr, 1.0f / 384.0f, rs);
#pragma unroll
        for (int ai = 0; ai < 2; ++ai)
#pragma unroll
            for (int m = 0; m < 4; ++m) { const int row = row0 + ai * HALF + m * 16; const float r = rs[ai][m] * qscale;
                if (u.pn < 4) {
#pragma unroll
                    for (int bj = 0; bj < 2; ++bj) *(u32x4*)(Q + (size_t)row * 1536 + (2 * u.pn + bj) * 192 + wc * 32 + 8 * fq) = pk8(acc[ai][bj][m][0] * r, acc[ai][bj][m][1] * r);
                } else { f32x4 o1[2], o2[2];
#pragma unroll
                    for (int n = 0; n < 2; ++n) { const f32x4 x1 = acc[ai][0][m][n] * r, x2 = acc[ai][1][m][n] * r; const float* cs = CS + ((size_t)row * 32 + 8 * fq + 4 * n) * 2;
                        const f32x4 c01 = *(const f32x4*)cs, c23 = *(const f32x4*)(cs + 4);
                        const f32x4 co = {c01[0], c01[2], c23[0], c23[2]}, si = {c01[1], c01[3], c23[1], c23[3]};
                        o1[n] = x1 * co - x2 * si; o2[n] = x1 * si + x2 * co; }
                    bf16_t* qp = Q + (size_t)row * 1536 + (4 * (u.pn - 4) + wc) * 192 + 128 + 8 * fq;
                    *(u32x4*)qp = pk8(o1[0], o1[1]); *(u32x4*)(qp + 32) = pk8(o2[0], o2[1]); } }
    }
};

template <class Epi, class Sched, bool ALIGN_EPI = false, bool SP2 = false>
__device__ __forceinline__ void gemm_phase(PG8_LAS unsigned char* lds, const Gemm g, const Sched& S, const Epi& E) {
    int tid_ = threadIdx.x; asm volatile("" : "+v"(tid_));
    const int tid = tid_, wid = __builtin_amdgcn_readfirstlane(tid >> 6), lane = tid & 63, wr = wid >> 2, wc = wid & 3, fr = lane & 15, fq = lane >> 4;
    const int K = g.K, nt = K / BK;
    unsigned voffA[2], voffB[2];
#pragma unroll
    for (int i = 0; i < 2; ++i) { int R, C; stage_rc(tid * 16 + i * 8192, R, C); const int Rb = Epi::PERM ? ((R & ~31) + perm32(R & 31)) : R;
        voffA[i] = (unsigned)(R * K + C) * 2u; voffB[i] = (unsigned)(Rb * K + C) * 2u; }
    const size_t kstep = (size_t)(BK * 2);
    const size_t hstep = (size_t)HALF * K * 2;
    const size_t tstep = 2 * hstep;
    const unsigned ldsw = (unsigned)wid * 1024u;
    const int aoff = lds_byte(wr * 64 + fr, fq * 8), boff = lds_byte(wc * 32 + fr, fq * 8);
#define PG8_SA(b, h) (((b) * 2 + (h)) * HTB)
#define PG8_SB(b, h) ((4 + (b) * 2 + (h)) * HTB)
#define PG8_STAGE(bufoff, gbase, voff) do { _Pragma("unroll") for (int _i = 0; _i < 2; ++_i) \
        __builtin_amdgcn_global_load_lds((const unsigned*)((const char*)(gbase) + (voff)[_i]), (PG8_LAS unsigned*)(lds + (bufoff) + ldsw + _i * 8192), 16, 0, 0); } while (0)
#define PG8_LDA(dst, b, h) do { _Pragma("unroll") for (int m = 0; m < 4; ++m) _Pragma("unroll") for (int k = 0; k < 2; ++k) dst[m][k] = *(const PG8_LAS bf16x8*)(lds + PG8_SA(b, h) + aoff + m * 2048 + k * 1024); } while (0)
#define PG8_LDB(dst, b, h) do { _Pragma("unroll") for (int n = 0; n < 2; ++n) _Pragma("unroll") for (int k = 0; k < 2; ++k) dst[n][k] = *(const PG8_LAS bf16x8*)(lds + PG8_SB(b, h) + boff + n * 2048 + k * 1024); } while (0)
#define PG8_MMA(ai, bj, At, Bt) do { __builtin_amdgcn_s_setprio(1); _Pragma("unroll") for (int m = 0; m < 4; ++m) _Pragma("unroll") for (int n = 0; n < 2; ++n) _Pragma("unroll") for (int k = 0; k < 2; ++k) \
        acc[ai][bj][m][n] = __builtin_amdgcn_mfma_f32_16x16x32_bf16(Bt[n][k], At[m][k], acc[ai][bj][m][n], 0, 0, 0); __builtin_amdgcn_s_setprio(0); } while (0)
#define PG8_WAIT_V(n) asm volatile("s_waitcnt vmcnt(" #n ")" ::: "memory")
#define PG8_WAIT_L(n) asm volatile("s_waitcnt lgkmcnt(" #n ")" ::: "memory")
#define PG8_BAR __builtin_amdgcn_s_barrier()
#define PG8_SCHED __builtin_amdgcn_sched_barrier(0)
    Unit cur, nxt; int ui = 0;
    if (!S.next(0, cur)) return;
    f32x4 acc[2][2][4][2];
#pragma unroll
    for (int a = 0; a < 2; ++a)
#pragma unroll
        for (int b = 0; b < 2; ++b)
#pragma unroll
            for (int m = 0; m < 4; ++m)
#pragma unroll
                for (int n = 0; n < 2; ++n) acc[a][b][m][n] = (f32x4){0.f, 0.f, 0.f, 0.f};
    bf16x8 At[4][2], B0[2][2], B1[2][2];
    const char* cA = (const char*)g.A + (size_t)cur.pm * tstep; const char* cB = (const char*)g.Bt + (size_t)cur.pn * tstep;
    S.a_ready(cur);
    if constexpr (SP2) {
        PG8_STAGE(PG8_SB(0, 0), cB, voffB); PG8_STAGE(PG8_SB(0, 1), cB + hstep, voffB); PG8_STAGE(PG8_SA(0, 0), cA, voffA); PG8_STAGE(PG8_SA(0, 1), cA + hstep, voffA);
        if (wr == 1) PG8_BAR;
        PG8_WAIT_V(2); PG8_BAR;
        PG8_STAGE(PG8_SB(1, 0), cB + kstep, voffB); PG8_STAGE(PG8_SA(1, 0), cA + kstep, voffA); PG8_STAGE(PG8_SB(1, 1), cB + hstep + kstep, voffB);
        PG8_WAIT_V(6); PG8_BAR;
    } else {
        PG8_STAGE(PG8_SB(0, 0), cB, voffB); PG8_STAGE(PG8_SA(0, 0), cA, voffA); PG8_STAGE(PG8_SB(0, 1), cB + hstep, voffB); PG8_STAGE(PG8_SA(0, 1), cA + hstep, voffA);
        if (wr == 1) PG8_BAR;
        PG8_WAIT_V(4); PG8_BAR;
        PG8_STAGE(PG8_SB(1, 0), cB + kstep, voffB); PG8_STAGE(PG8_SA(1, 0), cA + kstep, voffA); PG8_STAGE(PG8_SB(1, 1), cB + hstep + kstep, voffB);
        PG8_WAIT_V(6); PG8_BAR;
    }
    for (;;) {
        const bool has_next = S.next(ui + 1, nxt);
        const char* nA = has_next ? (const char*)g.A + (size_t)nxt.pm * tstep : cA; const char* nB = has_next ? (const char*)g.Bt + (size_t)nxt.pn * tstep : cB;
        for (int t = 0; t < nt; t += 2) {
            const bool last = (t == nt - 2);
            const char* a1 = cA + (size_t)(t + 1) * kstep;
            const char* a2 = last ? nA : cA + (size_t)(t + 2) * kstep; const char* b2 = last ? nB : cB + (size_t)(t + 2) * kstep;
            const char* a3 = a2 + kstep; const char* b3 = b2 + kstep;
            if (last && has_next) S.a_ready(nxt);
            if constexpr (SP2) {
            PG8_LDB(B0, 0, 0); PG8_LDB(B1, 0, 1); PG8_SCHED; PG8_LDA(At, 0, 0); PG8_STAGE(PG8_SA(1, 1), a1 + hstep, voffA);
            PG8_WAIT_V(8); PG8_WAIT_L(0); PG8_BAR; PG8_MMA(0, 0, At, B0); PG8_MMA(0, 1, At, B1); PG8_BAR; PG8_SCHED;
            PG8_LDA(At, 0, 1); PG8_STAGE(PG8_SB(0, 0), b2, voffB); PG8_STAGE(PG8_SB(0, 1), b2 + hstep, voffB); PG8_STAGE(PG8_SA(0, 0), a2, voffA);
            PG8_WAIT_V(8); PG8_WAIT_L(0); PG8_BAR; PG8_MMA(1, 0, At, B0); PG8_MMA(1, 1, At, B1); PG8_BAR; PG8_SCHED;
            PG8_LDB(B0, 1, 0); PG8_LDB(B1, 1, 1); PG8_SCHED; PG8_LDA(At, 1, 0); PG8_STAGE(PG8_SA(0, 1), a2 + hstep, voffA);
            PG8_WAIT_V(8); PG8_WAIT_L(0); PG8_BAR; PG8_MMA(0, 0, At, B0); PG8_MMA(0, 1, At, B1); PG8_BAR; PG8_SCHED;
            PG8_LDA(At, 1, 1); PG8_STAGE(PG8_SB(1, 0), b3, voffB); PG8_STAGE(PG8_SB(1, 1), b3 + hstep, voffB); PG8_STAGE(PG8_SA(1, 0), a3, voffA);
            PG8_WAIT_V(8); PG8_WAIT_L(0); PG8_BAR; PG8_MMA(1, 0, At, B0); PG8_MMA(1, 1, At, B1); PG8_BAR; PG8_SCHED;
            } else {
            PG8_LDB(B0, 0, 0); PG8_SCHED; PG8_LDA(At, 0, 0); PG8_STAGE(PG8_SA(1, 1), a1 + hstep, voffA);
            PG8_WAIT_L(8); PG8_BAR; PG8_WAIT_L(0); PG8_MMA(0, 0, At, B0); PG8_BAR; PG8_SCHED;
            PG8_LDB(B1, 0, 1); PG8_STAGE(PG8_SB(0, 0), b2, voffB);
            PG8_BAR; PG8_WAIT_L(0); PG8_MMA(0, 1, At, B1); PG8_BAR;
            PG8_LDA(At, 0, 1); PG8_STAGE(PG8_SA(0, 0), a2, voffA);
            PG8_BAR; PG8_WAIT_L(0); PG8_MMA(1, 0, At, B0); PG8_BAR; PG8_SCHED;
            PG8_STAGE(PG8_SB(0, 1), b2 + hstep, voffB);
            PG8_WAIT_V(6); PG8_BAR; PG8_MMA(1, 1, At, B1); PG8_BAR;
            PG8_LDB(B0, 1, 0); PG8_SCHED; PG8_LDA(At, 1, 0); PG8_STAGE(PG8_SA(0, 1), a2 + hstep, voffA);
            PG8_WAIT_L(8); PG8_BAR; PG8_WAIT_L(0); PG8_MMA(0, 0, At, B0); PG8_BAR; PG8_SCHED;
            PG8_LDB(B1, 1, 1); PG8_STAGE(PG8_SB(1, 0), b3, voffB);
            PG8_BAR; PG8_WAIT_L(0); PG8_MMA(0, 1, At, B1); PG8_BAR;
            PG8_LDA(At, 1, 1); PG8_STAGE(PG8_SA(1, 0), a3, voffA);
            PG8_BAR; PG8_WAIT_L(0); PG8_MMA(1, 0, At, B0); PG8_BAR; PG8_SCHED;
            PG8_STAGE(PG8_SB(1, 1), b3 + hstep, voffB);
            PG8_WAIT_V(6); PG8_BAR; PG8_MMA(1, 1, At, B1); PG8_BAR;
            }
        }
        if constexpr (ALIGN_EPI) { if (wr == 0) PG8_BAR; }
        if constexpr (!Epi::AFTER_DRAIN) { E(acc, cur, wr, wc, fr, fq); S.done(cur); }
        if (!has_next) break;
#pragma unroll
        for (int a = 0; a < 2; ++a)
#pragma unroll
            for (int b = 0; b < 2; ++b)
#pragma unroll
                for (int m = 0; m < 4; ++m)
#pragma unroll
                    for (int n = 0; n < 2; ++n) acc[a][b][m][n] = (f32x4){0.f, 0.f, 0.f, 0.f};
        cur = nxt; cA = nA; cB = nB; ++ui;
        if constexpr (ALIGN_EPI) { if (wr == 1) PG8_BAR; }
    }
    PG8_WAIT_V(0);
    if constexpr (!ALIGN_EPI) { if (wr == 0) PG8_BAR; }
    PG8_BAR;
    if constexpr (Epi::AFTER_DRAIN) { E.fused(acc, cur, wr, wc, fr, fq, lds, wid, lane); S.done(cur); }
#undef PG8_SA
#undef PG8_SB
#undef PG8_STAGE
#undef PG8_LDA
#undef PG8_LDB
#undef PG8_MMA
#undef PG8_WAIT_V
#undef PG8_WAIT_L
#undef PG8_BAR
#undef PG8_SCHED
}}

#define LAS __attribute__((address_space(3)))
typedef unsigned short bf16_t;
typedef short bf16x8 __attribute__((ext_vector_type(8)));
typedef float f32x4 __attribute__((ext_vector_type(4)));
typedef float f32x16 __attribute__((ext_vector_type(16)));
typedef unsigned u32x4 __attribute__((ext_vector_type(4)));
typedef unsigned u32x2 __attribute__((ext_vector_type(2)));
using pg8::pk_bf16; using pg8::pk8;

namespace att {
constexpr int KROW = 400, KTILE = 64 * KROW, VROW = 144, VTILE = 128 * VROW, BUF = KTILE + VTILE;
__device__ __forceinline__ int crow(int r, int hi) { return (r & 3) + 8 * (r >> 2) + 4 * hi; }
#define ATT_MFMA(a, b, c) __builtin_amdgcn_mfma_f32_32x32x16_bf16((a), (b), (c), 0, 0, 0)
#define ATT_SB() __builtin_amdgcn_sched_barrier(0)
__device__ __forceinline__ float max3f(float a, float b, float c) { float r; asm("v_max3_f32 %0, %1, %2, %3" : "=v"(r) : "v"(a), "v"(b), "v"(c)); return r; }
__device__ __forceinline__ void attn_unit(int b, int h, int qb, const bf16_t* __restrict__ Q, const bf16_t* __restrict__ KN, const bf16_t* __restrict__ KPE, const bf16_t* __restrict__ VT, bf16_t* __restrict__ O, LAS unsigned char* lds) {
    int tid_ = threadIdx.x; asm volatile("" : "+v"(tid_));
    const int tid = tid_, lane = tid & 63, wid = __builtin_amdgcn_readfirstlane(tid >> 6), q32 = lane & 31, hi = lane >> 5;
    const int q0 = qb * 256; const size_t tok0 = (size_t)b * SEQ;
    const int qrow = q0 + wid * 32 + q32;
    bf16x8 qf[12];
    { const bf16_t* qp = Q + (tok0 + qrow) * 1536 + h * 192 + hi * 8;
#pragma unroll
      for (int s = 0; s < 12; ++s) qf[s] = *(const bf16x8*)(qp + s * 16); }
    const char* kbase = (const char*)(KN + tok0 * 1024 + h * 128); const char* pbase = (const char*)(KPE + tok0 * 64); const char* vbase = (const char*)(VT + (size_t)(b * 8 + h) * 128 * 2048);
#define ATT_RETID() int t2_ = tid; asm volatile("" : "+v"(t2_)); const unsigned srow_ = (unsigned)t2_ >> 3, spart_ = (unsigned)t2_ & 7u
    const int NT = (q0 + 256) / 64;
    u32x4 rb0, rb1, rb2, rb3, rb4;
#define ATT_LOAD(t, R0, R1, R2, R3, R4) do { ATT_RETID(); const unsigned koff = srow_ * 2048 + spart_ * 16, poff = srow_ * 128 + spart_ * 16, voff = srow_ * 4096 + spart_ * 16; \
        const char* kb_ = kbase + (size_t)(t) * (64 * 2048); const char* pb_ = pbase + (size_t)(t) * (64 * 128); const char* vb_ = vbase + (size_t)(t) * 128; \
        R0 = *(const u32x4*)(kb_ + koff); R1 = *(const u32x4*)(kb_ + 128 + koff); R2 = *(const u32x4*)(pb_ + poff); R3 = *(const u32x4*)(vb_ + voff); R4 = *(const u32x4*)(vb_ + 64 * 4096 + voff); } while (0)
#define ATT_STORE(bo, R0, R1, R2, R3, R4) do { ATT_RETID(); const unsigned kdst = srow_ * KROW + spart_ * 16, vdst = KTILE + srow_ * VROW + (spart_ >> 1) * 32 + (spart_ & 1) * 8; LAS unsigned char* b_ = lds + (bo); \
        *(LAS u32x4*)(b_ + kdst) = R0; *(LAS u32x4*)(b_ + kdst + 128) = R1; *(LAS u32x4*)(b_ + kdst + 256) = R2; \
        *(LAS u32x2*)(b_ + vdst) = (u32x2){R3.x, R3.y}; *(LAS u32x2*)(b_ + vdst + 16) = (u32x2){R3.z, R3.w}; \
        *(LAS u32x2*)(b_ + vdst + 64 * VROW) = (u32x2){R4.x, R4.y}; *(LAS u32x2*)(b_ + vdst + 64 * VROW + 16) = (u32x2){R4.z, R4.w}; } while (0)
#define ATT_LOAD_B(t) ATT_LOAD(t, rb0, rb1, rb2, rb3, rb4)
#define ATT_STORE_B(bo) ATT_STORE(bo, rb0, rb1, rb2, rb3, rb4)
    f32x16 o[4];
#pragma unroll
    for (int d = 0; d < 4; ++d)
#pragma unroll
        for (int r = 0; r < 16; ++r) o[d][r] = 0.f;
    float mrun = 0.f, lrun = 0.f;
    f32x16 negm;
#pragma unroll
    for (int r = 0; r < 16; ++r) negm[r] = 0.f;
    ATT_LOAD_B(0); ATT_STORE_B(0); __syncthreads();
#define ATT_COMPUTE(t_) do { const int t = (t_); const int cur = (t & 1) * BUF, k0 = t * 64; \
        if (k0 <= q0 + wid * 32 + 31) { \
            f32x16 s0 = negm, s1 = negm; \
            const LAS unsigned char* kb = lds + cur + q32 * KROW + hi * 16; \
            bf16x8 ka[2][2]; \
            ATT_SB(); \
        _Pragma("unroll") \
            for (int st = 0; st < 2; ++st) { ka[st][0] = *(const LAS bf16x8*)(kb + st * 32); ka[st][1] = *(const LAS bf16x8*)(kb + 32 * KROW + st * 32); } \
            ATT_SB(); \
        _Pragma("unroll") \
            for (int st = 0; st < 12; ++st) { \
                s0 = ATT_MFMA(ka[st & 1][0], qf[st], s0); s1 = ATT_MFMA(ka[st & 1][1], qf[st], s1); \
                ATT_SB(); \
                if (st + 2 < 12) { ka[st & 1][0] = *(const LAS bf16x8*)(kb + (st + 2) * 32); ka[st & 1][1] = *(const LAS bf16x8*)(kb + 32 * KROW + (st + 2) * 32); ATT_SB(); } \
            } \
            asm volatile("s_nop 15\n\ts_nop 7" : "+v"(s0), "+v"(s1));     \
            if (k0 + 63 > q0 + wid * 32) { \
        _Pragma("unroll") \
                for (int r = 0; r < 16; ++r) { const int key = k0 + crow(r, hi); if (key > qrow) s0[r] = -INFINITY; if (key + 32 > qrow) s1[r] = -INFINITY; } \
            } \
            float mxa = max3f(s0[0], s0[1], s1[0]), mxb = max3f(s0[2], s0[3], s1[1]); mxa = max3f(mxa, s1[2], s1[3]); \
        _Pragma("unroll") \
            for (int r = 4; r < 16; r += 4) { mxa = max3f(mxa, s0[r], s0[r + 1]); mxb = max3f(mxb, s0[r + 2], s0[r + 3]); mxa = max3f(mxa, s1[r], s1[r + 1]); mxb = max3f(mxb, s1[r + 2], s1[r + 3]); } \
            float mx = max3f(mxa, mxb, mxb); \
            { auto rr = __builtin_amdgcn_permlane32_swap(__float_as_uint(mx), __float_as_uint(mx), false, false); mx = max3f(__uint_as_float(rr[0]), __uint_as_float(rr[1]), mx); } \
            if (t == 0 || __any(mx > 8.0f)) {        \
                const float dl = (t == 0) ? mx : fmaxf(mx, 0.f), alpha = (t == 0) ? 1.0f : __builtin_amdgcn_exp2f(-dl); mrun += dl; lrun *= alpha; \
        _Pragma("unroll") \
                for (int r = 0; r < 16; ++r) { s0[r] -= dl; s1[r] -= dl; negm[r] = -mrun; } \
        _Pragma("unroll") \
                for (int d = 0; d < 4; ++d) \
        _Pragma("unroll") \
                    for (int r = 0; r < 16; ++r) o[d][r] *= alpha; } \
            const LAS unsigned char* vb = lds + cur + KTILE + q32 * VROW + hi * 16; \
            bf16x8 va[2][4]; \
            ATT_SB(); \
        _Pragma("unroll") \
            for (int d = 0; d < 4; ++d) va[0][d] = *(const LAS bf16x8*)(vb + d * 32 * VROW); \
            ATT_SB(); \
              \
        _Pragma("unroll") \
            for (int r = 0; r < 16; ++r) s0[r] = __builtin_amdgcn_exp2f(s0[r]); \
            bf16x8 pk[4]; \
            { u32x4 w; \
              w.x = pk_bf16(s0[0], s0[1]); w.y = pk_bf16(s0[2], s0[3]); w.z = pk_bf16(s0[4], s0[5]); w.w = pk_bf16(s0[6], s0[7]); pk[0] = __builtin_bit_cast(bf16x8, w); \
              w.x = pk_bf16(s0[8], s0[9]); w.y = pk_bf16(s0[10], s0[11]); w.z = pk_bf16(s0[12], s0[13]); w.w = pk_bf16(s0[14], s0[15]); pk[1] = __builtin_bit_cast(bf16x8, w); } \
            ATT_SB(); \
        _Pragma("unroll") \
            for (int j = 0; j < 2; ++j) { \
        _Pragma("unroll") \
                for (int d = 0; d < 4; ++d) { \
                    va[(j + 1) & 1][d] = *(const LAS bf16x8*)(vb + d * 32 * VROW + (j + 1) * 32); \
                    o[d] = ATT_MFMA(va[j & 1][d], pk[j], o[d]); \
                    s1[(j * 4 + d) * 2] = __builtin_amdgcn_exp2f(s1[(j * 4 + d) * 2]); s1[(j * 4 + d) * 2 + 1] = __builtin_amdgcn_exp2f(s1[(j * 4 + d) * 2 + 1]); \
                    ATT_SB(); } } \
            { u32x4 w; \
              w.x = pk_bf16(s1[0], s1[1]); w.y = pk_bf16(s1[2], s1[3]); w.z = pk_bf16(s1[4], s1[5]); w.w = pk_bf16(s1[6], s1[7]); pk[2] = __builtin_bit_cast(bf16x8, w); \
              w.x = pk_bf16(s1[8], s1[9]); w.y = pk_bf16(s1[10], s1[11]); w.z = pk_bf16(s1[12], s1[13]); w.w = pk_bf16(s1[14], s1[15]); pk[3] = __builtin_bit_cast(bf16x8, w); } \
            ATT_SB(); \
            float ls = 0.f; \
        _Pragma("unroll") \
            for (int j = 2; j < 4; ++j) { \
        _Pragma("unroll") \
                for (int d = 0; d < 4; ++d) { \
                    if (j + 1 < 4) va[(j + 1) & 1][d] = *(const LAS bf16x8*)(vb + d * 32 * VROW + (j + 1) * 32); \
                    o[d] = ATT_MFMA(va[j & 1][d], pk[j], o[d]); \
                    { const int q4 = ((j - 2) * 4 + d) * 2; ls += (s0[q4] + s0[q4 + 1]) + (s1[q4] + s1[q4 + 1]); } \
                    ATT_SB(); } } \
            lrun += ls; \
        } \
    } while (0)
    for (int tt = 0; tt < NT; tt += 2) {
        ATT_LOAD_B(tt + 1);
        ATT_COMPUTE(tt);
        ATT_STORE_B(BUF);
        __syncthreads();
        ATT_LOAD_B(tt + 2 < NT ? tt + 2 : NT - 1);
        ATT_COMPUTE(tt + 1);
        if (tt + 2 < NT) ATT_STORE_B(0);
        __syncthreads();
    }
#undef ATT_COMPUTE
    const float ltot = lrun + __shfl_xor(lrun, 32), inv = 1.0f / ltot;
    bf16_t* op = O + (tok0 + qrow) * 1024 + h * 128 + 8 * hi;
#pragma unroll
    for (int d = 0; d < 4; ++d)
#pragma unroll
        for (int k = 0; k < 2; ++k) { const int g0 = 2 * k, g1 = 2 * k + 1;
            unsigned a0 = pk_bf16(o[d][4 * g0] * inv, o[d][4 * g0 + 1] * inv), a1 = pk_bf16(o[d][4 * g0 + 2] * inv, o[d][4 * g0 + 3] * inv);
            unsigned b0 = pk_bf16(o[d][4 * g1] * inv, o[d][4 * g1 + 1] * inv), b1 = pk_bf16(o[d][4 * g1 + 2] * inv, o[d][4 * g1 + 3] * inv);
            auto r0 = __builtin_amdgcn_permlane32_swap(a0, b0, false, false); auto r1 = __builtin_amdgcn_permlane32_swap(a1, b1, false, false);
            u32x4 w; w.x = r0[0]; w.y = r1[0]; w.z = r0[1]; w.w = r1[1];
            *(u32x4*)(op + d * 32 + k * 16) = w; }
#undef ATT_LOAD
#undef ATT_STORE
#undef ATT_RETID
#undef ATT_LOAD_B
#undef ATT_STORE_B
}
__device__ __forceinline__ void attn_phase(const bf16_t* Q, const bf16_t* KN, const bf16_t* KPE, const bf16_t* VT, bf16_t* O, LAS unsigned char* lds) {
    const int G = gridDim.x, bx = blockIdx.x, vcu = (G % 8 == 0) ? (bx % 8) * (G / 8) + bx / 8 : bx;
    for (int p = vcu; p < 512; p += G) { const int bh = p >> 2, s = p & 3;
        attn_unit(bh >> 3, bh & 7, 7 - s, Q, KN, KPE, VT, O, lds);
        attn_unit(bh >> 3, bh & 7, s, Q, KN, KPE, VT, O, lds); }
}
}

typedef unsigned v4u __attribute__((ext_vector_type(4)));
#define XB_TMO      128
#define XB_XCNT(j)  (256  + 64 * (j))
#define XB_XSUB(j)  (1280 + 64 * (j))
#define XB_XGEN(j)  (2304 + 64 * (j))
#define XB_TOP      3328
#define XB_TOPGEN   3392
#define XCD_BAR_WORDS 3456
#define XB_SPIN_CAP (1u << 18)

__device__ __forceinline__ unsigned xb_ld(unsigned* p)              { return __hip_atomic_load(p, __ATOMIC_RELAXED, __HIP_MEMORY_SCOPE_AGENT); }
__device__ __forceinline__ unsigned xb_add(unsigned* p, unsigned v) { return __hip_atomic_fetch_add(p, v, __ATOMIC_RELAXED, __HIP_MEMORY_SCOPE_AGENT); }
__device__ __forceinline__ unsigned xb_xcc_id() { return (unsigned)__builtin_amdgcn_s_getreg((3 << 11) | 20) & 0xFu; }
#define XB_SPIN(cond, bar) do { unsigned _sp = 0; while (cond) { __builtin_amdgcn_s_sleep(1); \
    if ((++_sp & 255u) == 0u) { if (xb_ld(&(bar)[XB_TMO])) break; if (_sp > XB_SPIN_CAP) { atomicAdd(&(bar)[XB_TMO], 1u); break; } } } } while (0)

struct XcdBarrier {
    unsigned* bar; unsigned x;
    volatile LAS unsigned* st;
};

__device__ __forceinline__ XcdBarrier xcd_barrier_post(unsigned* bar, volatile LAS unsigned* st) {
    XcdBarrier b; b.bar = bar; b.x = xb_xcc_id(); b.st = st;
    if (threadIdx.x == 0) (void)xb_add(&bar[XB_XCNT(b.x)], 1u);
    return b;
}
__device__ __forceinline__ void xcd_barrier_complete(unsigned* bar, unsigned x, unsigned& nloc, unsigned& nx) {
    const unsigned G = gridDim.x * gridDim.y * gridDim.z;
    unsigned sum, cnt, mine, sp = 0u;
    for (;;) {
        sum = 0u; cnt = 0u; mine = 0u;
#pragma unroll
        for (unsigned j = 0; j < 16; ++j) { const unsigned c = xb_ld(&bar[XB_XCNT(j)]); sum += c; cnt += (c > 0u) ? 1u : 0u; mine = (j == x) ? c : mine; }
        if (sum == G) break;
        __builtin_amdgcn_s_sleep(1);
        if ((++sp & 255u) == 0u) { if (xb_ld(&bar[XB_TMO])) break; if (sp > XB_SPIN_CAP) { atomicAdd(&bar[XB_TMO], 1u); break; } }
    }
    nloc = mine > 0u ? mine : 1u; nx = cnt > 0u ? cnt : 1u;
}

__device__ __forceinline__ void xcd_barrier(const XcdBarrier& b) {
    asm volatile("s_waitcnt vmcnt(0)" ::: "memory");
    __syncthreads();
    if (threadIdx.x == 0) {
        unsigned* bar = b.bar;
        __builtin_amdgcn_s_waitcnt(0);
        unsigned nloc = b.st[0], nx = b.st[1];
        if (nloc == 0u) { xcd_barrier_complete(bar, b.x, nloc, nx); b.st[0] = nloc; b.st[1] = nx; }
        const unsigned old = xb_add(&bar[XB_XSUB(b.x)], 1u);
        const unsigned gen = old / nloc;
        if (old + 1u == (gen + 1u) * nloc) {
            __builtin_amdgcn_fence(__ATOMIC_RELEASE, "agent");
            asm volatile("s_waitcnt vmcnt(0)" ::: "memory");
            const unsigned og = xb_add(&bar[XB_TOP], 1u);
            const unsigned tg = og / nx;
            if (og + 1u == (tg + 1u) * nx) xb_add(&bar[XB_TOPGEN], 1u);
            else XB_SPIN(xb_ld(&bar[XB_TOPGEN]) == tg, bar);
            __builtin_amdgcn_fence(__ATOMIC_ACQUIRE, "agent");
            xb_add(&bar[XB_XGEN(b.x)], 1u);
            asm volatile("s_waitcnt vmcnt(0)" ::: "memory");
        } else {
            XB_SPIN(xb_ld(&bar[XB_XGEN(b.x)]) == gen, bar);
            __builtin_amdgcn_fence(__ATOMIC_ACQUIRE, "agent");
            asm volatile("s_waitcnt vmcnt(0)" ::: "memory");
        }
    }
    __syncthreads();
}

constexpr size_t MiB = 1u << 20;
constexpr size_t WS_BAR = 2 * MiB + 512 * 1024, BAR_BYTES = 16384;
constexpr size_t WS_SSQH = 0, WS_SSQL = 2 * MiB, WS_SSQQ = 3 * MiB, WS_CS = 4 * MiB, WS_HB = 12 * MiB, WS_W = 76 * MiB;
constexpr size_t SZ_WIN = (size_t)3072 * 1024 * 2, SZ_WSQ = (size_t)1024 * 1024 * 2, SZ_W13 = (size_t)5632 * 1024 * 2, SZ_W2 = (size_t)1024 * 2816 * 2;
constexpr size_t OW_WIN = 0, OW_WOUT = SZ_WIN, OW_CW13 = SZ_WIN + SZ_WSQ, OW_CW2 = OW_CW13 + SZ_W13, SZ_CONV = OW_CW2 + SZ_W2;
constexpr size_t OW_DKVQ = 2 * SZ_CONV, OW_WK = OW_DKVQ + SZ_WSQ, SZ_WK = (size_t)1024 * 256 * 2, OW_WVT = OW_WK + SZ_WK;
constexpr size_t OW_WUQ = OW_WVT + SZ_WK, SZ_WUQ = (size_t)1536 * 384 * 2, OW_WDQ1 = OW_WUQ + 2 * SZ_WUQ, SZ_WDQ1 = (size_t)512 * 1024 * 2;
constexpr size_t OW_WO = OW_WDQ1 + SZ_WDQ1, OW_MW13 = OW_WO + 2 * SZ_WSQ, OW_MW2 = OW_MW13 + 2 * SZ_W13, SZ_WALL = OW_MW2 + 2 * SZ_W2;
static_assert(SZ_WALL <= 93 * MiB, "weights");
constexpr size_t WS_KN = 169 * MiB, WS_VT = 233 * MiB, WS_KPE = 297 * MiB, WS_ACT = 301 * MiB, WS_END = 477 * MiB;
constexpr size_t WS_Z = WS_KN, WS_GB = WS_VT, WS_Y = WS_ACT;
constexpr size_t WS_Q = WS_ACT, WS_ATT = WS_ACT + 96 * MiB, WS_CLAT = WS_ACT + 96 * MiB, WS_CQ = WS_ACT + 112 * MiB;

constexpr int LDS_BYTES = 136192;

struct Params { const float* in[22]; float* out; unsigned char* ws; };

__device__ __forceinline__ float wave_sum(float v) {
#pragma unroll
    for (int o = 1; o < 64; o <<= 1) v += __shfl_xor(v, o);
    return v;
}
template <int MAP> __device__ __forceinline__ int map_src(int n0) {
    if (MAP == 0) return n0;
    if (MAP == 1) { if (n0 < 2048) { const int pn = n0 >> 8, bj = (n0 >> 7) & 1, i = n0 & 127; return 1024 + 1024 * bj + 128 * pn + i; } return n0 - 2048; }
    if (MAP == 2) { const int pn = n0 >> 8, bj = (n0 >> 7) & 1, i = n0 & 127; return bj * 2816 + 128 * pn + i; }
    if (MAP == 3) { if (n0 < 256) return n0; const int i = n0 - 256, bj = i >> 7, ii = i & 127; return ii == 0 ? 256 + 32 * bj : -1; }
    if (MAP == 4) return n0 < 384 ? n0 : -1;
    if (MAP == 5) { const int hh = n0 >> 7, i = n0 & 127; return 256 * hh + i; }
    if (MAP == 6) { const int hh = n0 >> 7, i = n0 & 127; return 256 * hh + 128 + i; }
    if (MAP == 7) { if (n0 < 1024) { const int hh = n0 >> 7, i = n0 & 127; return 192 * hh + i; }
                    const int q = n0 - 1024, pnr = q >> 8, bj = (q >> 7) & 1, i = q & 127, hh = 4 * pnr + (i >> 5); return 192 * hh + 128 + 32 * bj; }
    return n0;
}
template <int MAP> __device__ __forceinline__ void transpose_item(const float* __restrict__ W, int K, int Ns, int Nd, const float* __restrict__ gain, bf16_t* __restrict__ WT, LAS float* scr, int item, int lane) {
    const int nblk = Nd / 32, kb = item / nblk, nb = item - kb * nblk, k0 = 64 * kb, n0 = 32 * nb;
    const int src = map_src<MAP>(n0);
    float v[32];
    if (src >= 0) { const float* wp = W + (size_t)(k0 + (lane >> 5)) * Ns + src + (lane & 31);
#pragma unroll
        for (int i = 0; i < 32; ++i) v[i] = __builtin_nontemporal_load(wp + (size_t)(2 * i) * Ns);
    } else {
#pragma unroll
        for (int i = 0; i < 32; ++i) v[i] = 0.f; }
    const int c = lane & 7;
    f32x4 g0 = {1.f, 1.f, 1.f, 1.f}, g1 = g0;
    if (gain) { g0 = *(const f32x4*)(gain + k0 + 8 * c); g1 = *(const f32x4*)(gain + k0 + 8 * c + 4); }
#pragma unroll
    for (int i = 0; i < 32; ++i) scr[(2 * i + (lane >> 5)) * 33 + (lane & 31)] = v[i];
    asm volatile("s_waitcnt lgkmcnt(0)" ::: "memory");
#pragma unroll
    for (int j = 0; j < 4; ++j) { const int n = (lane >> 3) + 8 * j; const LAS float* s = scr + (8 * c) * 33 + n;
        u32x4 o; o.x = pk_bf16(s[0 * 33] * g0[0], s[1 * 33] * g0[1]); o.y = pk_bf16(s[2 * 33] * g0[2], s[3 * 33] * g0[3]); o.z = pk_bf16(s[4 * 33] * g1[0], s[5 * 33] * g1[1]); o.w = pk_bf16(s[6 * 33] * g1[2], s[7 * 33] * g1[3]);
        *(u32x4*)(WT + (size_t)(n0 + n) * K + k0 + 8 * c) = o; }
    asm volatile("s_waitcnt lgkmcnt(0)" ::: "memory");
}

__device__ __forceinline__ void prologue(const Params& p, LAS unsigned char* lds) {
    int tid_ = threadIdx.x; asm volatile("" : "+v"(tid_));
    const int tid = tid_, lane = tid & 63, wave = __builtin_amdgcn_readfirstlane(tid >> 6);
    const int gw = blockIdx.x * 8 + wave, NGW = gridDim.x * 8;
    LAS float* scr = (LAS float*)(lds + wave * 16384);
    unsigned char* ws = p.ws; bf16_t* wb = (bf16_t*)(ws + WS_W);
    constexpr int I_WIN = 16 * 96, I_SQ = 16 * 32, I_W13 = 16 * 176, I_W2 = 44 * 32, I_DKV = 16 * 16, I_DQ = 16 * 16, I_WK = 4 * 32, I_WUQ = 6 * 48;
#define BFW(off) ((bf16_t*)((unsigned char*)wb + (off)))
    int base = 0;
#define JOB(MAP, W, K, Ns, Nd, G, DST, CNT) do { for (int it = (gw + NGW - base % NGW) % NGW; it < (CNT); it += NGW) transpose_item<MAP>((W), (K), (Ns), (Nd), (G), (DST), scr, it, lane); base += (CNT); } while (0)
    for (int l = 0; l < 2; ++l) {
        JOB(1, p.in[3] + (size_t)l * 1024 * 3072, 1024, 3072, 3072, p.in[2] + l * 1024, BFW(l * SZ_CONV + OW_WIN), I_WIN);
        JOB(0, p.in[5] + (size_t)l * 1024 * 1024, 1024, 1024, 1024, (const float*)nullptr, BFW(l * SZ_CONV + OW_WOUT), I_SQ);
        JOB(2, p.in[7] + (size_t)l * 1024 * 5632, 1024, 5632, 5632, p.in[6] + l * 1024, BFW(l * SZ_CONV + OW_CW13), I_W13);
        JOB(0, p.in[8] + (size_t)l * 2816 * 1024, 2816, 1024, 1024, (const float*)nullptr, BFW(l * SZ_CONV + OW_CW2), I_W2);
    }
    JOB(3, p.in[10], 1024, 320, 512, p.in[9], BFW(OW_DKVQ), I_DKV);
    JOB(4, p.in[14], 1024, 384, 512, p.in[13], BFW(OW_DKVQ + (size_t)512 * 1024 * 2), I_DQ);
    JOB(5, p.in[12], 256, 2048, 1024, p.in[11], BFW(OW_WK), I_WK);
    JOB(6, p.in[12], 256, 2048, 1024, p.in[11], BFW(OW_WVT), I_WK);
    JOB(4, p.in[14] + (size_t)1024 * 384, 1024, 384, 512, p.in[13] + 1024, BFW(OW_WDQ1), I_DQ);
    for (int j = 0; j < 2; ++j) {
        JOB(7, p.in[16] + (size_t)j * 384 * 1536, 384, 1536, 1536, p.in[15] + j * 384, BFW(OW_WUQ + j * SZ_WUQ), I_WUQ);
        JOB(0, p.in[17] + (size_t)j * 1024 * 1024, 1024, 1024, 1024, (const float*)nullptr, BFW(OW_WO + j * SZ_WSQ), I_SQ);
        JOB(2, p.in[19] + (size_t)j * 1024 * 5632, 1024, 5632, 5632, p.in[18] + j * 1024, BFW(OW_MW13 + j * SZ_W13), I_W13);
        JOB(0, p.in[20] + (size_t)j * 2816 * 1024, 2816, 1024, 1024, (const float*)nullptr, BFW(OW_MW2 + j * SZ_W2), I_W2);
    }
#undef JOB
#undef BFW
    { const float* x = p.in[0]; bf16_t* HB = (bf16_t*)(ws + WS_HB); float* ssq = (float*)(ws + WS_SSQH);
      for (int row0 = gw * 4; row0 < T_; row0 += NGW * 4) { f32x4 v[4][4];
#pragma unroll
          for (int r = 0; r < 4; ++r)
#pragma unroll
              for (int j = 0; j < 4; ++j) v[r][j] = __builtin_nontemporal_load((const f32x4*)(x + (size_t)(row0 + r) * 1024) + lane + 64 * j);
#pragma unroll
          for (int r = 0; r < 4; ++r) { float s = 0.f;
#pragma unroll
              for (int j = 0; j < 4; ++j) { s += pg8::dot4(v[r][j]); u32x2 w; w.x = pk_bf16(v[r][j][0], v[r][j][1]); w.y = pk_bf16(v[r][j][2], v[r][j][3]); *((u32x2*)(HB + (size_t)(row0 + r) * 1024) + lane + 64 * j) = w; }
              s = wave_sum(s); if (lane < 16) ssq[(size_t)(row0 + r) * 16 + lane] = lane == 0 ? s : 0.f; } } }
    { const int* pos = (const int*)p.in[1]; float* CS = (float*)(ws + WS_CS);
      for (int idx = blockIdx.x * 512 + tid; idx < T_ * 32; idx += gridDim.x * 512) { const int row = idx >> 5, j = idx & 31;
          double f = 1.0; for (int i = 0; i < j; ++i) f *= 0.74989420933245582730;
          const float ang = (float)pos[row] * (float)f;
          const double xr = (double)ang * 0.15915494309189533577; const float fr = (float)(xr - __builtin_rint(xr));
          CS[(size_t)idx * 2] = __builtin_amdgcn_cosf(fr); CS[(size_t)idx * 2 + 1] = __builtin_amdgcn_sinf(fr); } }
}

__device__ __forceinline__ void bf8_to_f32(const u32x4 v, float* f) {
#pragma unroll
    for (int i = 0; i < 4; ++i) { f[2 * i] = __uint_as_float(v[i] << 16); f[2 * i + 1] = __uint_as_float(v[i] & 0xffff0000u); }
}
__device__ __forceinline__ void conv_phase(const bf16_t* __restrict__ Z, const bf16_t* __restrict__ GB, const float* __restrict__ cw, bf16_t* __restrict__ Y) {
    int tid_ = threadIdx.x; asm volatile("" : "+v"(tid_));
    const int tid = tid_, c8 = (tid & 127) * 8, rg = tid >> 7;
    f32x4 w0a = *(const f32x4*)(cw + c8), w0b = *(const f32x4*)(cw + c8 + 4), w1a = *(const f32x4*)(cw + 1024 + c8), w1b = *(const f32x4*)(cw + 1024 + c8 + 4), w2a = *(const f32x4*)(cw + 2048 + c8), w2b = *(const f32x4*)(cw + 2048 + c8 + 4);
    for (int ch = blockIdx.x; ch < T_ / 64; ch += gridDim.x) { const int row0 = ch * 64 + rg * 16;
        f32x4 m2a = {0.f, 0.f, 0.f, 0.f}, m2b = m2a, m1a = m2a, m1b = m2a;
        if ((row0 & (SEQ - 1)) != 0) { float f[8]; bf8_to_f32(*(const u32x4*)(Z + (size_t)(row0 - 2) * 1024 + c8), f); m2a = (f32x4){f[0], f[1], f[2], f[3]}; m2b = (f32x4){f[4], f[5], f[6], f[7]};
            bf8_to_f32(*(const u32x4*)(Z + (size_t)(row0 - 1) * 1024 + c8), f); m1a = (f32x4){f[0], f[1], f[2], f[3]}; m1b = (f32x4){f[4], f[5], f[6], f[7]}; }
#pragma unroll 4
        for (int i = 0; i < 16; ++i) { const size_t off = (size_t)(row0 + i) * 1024 + c8; float f[8], g[8];
            bf8_to_f32(*(const u32x4*)(Z + off), f); bf8_to_f32(*(const u32x4*)(GB + off), g);
            const f32x4 za = {f[0], f[1], f[2], f[3]}, zb = {f[4], f[5], f[6], f[7]}, ga = {g[0], g[1], g[2], g[3]}, gb = {g[4], g[5], g[6], g[7]};
            const f32x4 ya = ga * (w0a * m2a + w1a * m1a + w2a * za), yb = gb * (w0b * m2b + w1b * m1b + w2b * zb);
            *(u32x4*)(Y + off) = pk8(ya, yb); m2a = m1a; m2b = m1b; m1a = za; m1b = zb; }
    }
}
__device__ __forceinline__ void final_norm(float* out, const bf16_t* hb, const float* ssq, const float* g) {
    int tid_ = threadIdx.x; asm volatile("" : "+v"(tid_));
    const int tid = tid_, lane = tid & 63, wave = tid >> 6; const int gw = blockIdx.x * 8 + wave, NGW = gridDim.x * 8;
    f32x4 gv[2][2];
#pragma unroll
    for (int j = 0; j < 2; ++j) { const int c = (lane + 64 * j) * 8; gv[j][0] = *(const f32x4*)(g + c); gv[j][1] = *(const f32x4*)(g + c + 4); }
    for (int row0 = gw * 2; row0 < T_; row0 += NGW * 2) {
        float r[2]; u32x4 v[2][2];
#pragma unroll
        for (int k = 0; k < 2; ++k) { r[k] = pg8::rstd_of<16>(ssq, row0 + k, 1.0f / 1024.0f);
#pragma unroll
            for (int j = 0; j < 2; ++j) v[k][j] = *(const u32x4*)(hb + (size_t)(row0 + k) * 1024 + (lane + 64 * j) * 8); }
        asm volatile("" ::: "memory");
#pragma unroll
        for (int k = 0; k < 2; ++k)
#pragma unroll
            for (int j = 0; j < 2; ++j) { const int c = (lane + 64 * j) * 8; float f[8]; bf8_to_f32(v[k][j], f);
                *(f32x4*)(out + (size_t)(row0 + k) * 1024 + c) = (f32x4){f[0], f[1], f[2], f[3]} * r[k] * gv[j][0]; *(f32x4*)(out + (size_t)(row0 + k) * 1024 + c + 4) = (f32x4){f[4], f[5], f[6], f[7]} * r[k] * gv[j][1]; } }
}

__device__ __forceinline__ void conv_fix_rows(const bf16_t* __restrict__ Z, const bf16_t* __restrict__ GB, const float* __restrict__ cw, bf16_t* __restrict__ Y, int M, int N) {
    int tid_ = threadIdx.x; asm volatile("" : "+v"(tid_));
    const int tid = tid_;
    pg8::StaticOrder S; S.init(M, N, (int)gridDim.x, (int)blockIdx.x); pg8::Unit u;
    if (tid < 256) { const int r = tid >> 7, c8 = (tid & 127) * 8;
        const f32x4 w0a = *(const f32x4*)(cw + c8), w0b = *(const f32x4*)(cw + c8 + 4), w1a = *(const f32x4*)(cw + 1024 + c8), w1b = *(const f32x4*)(cw + 1024 + c8 + 4), w2a = *(const f32x4*)(cw + 2048 + c8), w2b = *(const f32x4*)(cw + 2048 + c8 + 4);
        for (int i = 0; S.next(i, u); ++i) { const int row = u.pm * 256 + r, t = row & (SEQ - 1); const size_t off = (size_t)row * 1024 + c8;
            f32x4 za, zb, ga, gb, z1a = {0.f, 0.f, 0.f, 0.f}, z1b = z1a, z2a = z1a, z2b = z1a;
            pg8::unpack8(*(const u32x4*)(Z + off), za, zb); pg8::unpack8(*(const u32x4*)(GB + off), ga, gb);
            if (t >= 1) pg8::unpack8(*(const u32x4*)(Z + off - 1024), z1a, z1b);
            if (t >= 2) pg8::unpack8(*(const u32x4*)(Z + off - 2048), z2a, z2b);
            *(u32x4*)(Y + off) = pk8(ga * (w0a * z2a + w1a * z1a + w2a * za), gb * (w0b * z2b + w1b * z1b + w2b * zb)); } }
    asm volatile("s_waitcnt vmcnt(0)" ::: "memory"); __syncthreads();
}

#define GEMM_PHASE(EPI, A_, B_, M_, N_, K_, E_) do { int k_ = (K_); asm volatile("" : "+s"(k_)); pg8::Gemm g_{(const bf16_t*)(A_), (const bf16_t*)(B_), (M_), (N_), k_}; pg8::StaticOrder S_; S_.init((M_), (N_), (int)gridDim.x, (int)blockIdx.x); \
        pg8::gemm_phase<EPI, pg8::StaticOrder, true, true>(lds, g_, S_, (E_)); } while (0)

typedef __attribute__((address_space(1))) unsigned char gbyte_t;
__device__ __forceinline__ unsigned char* fresh(unsigned char* q) { gbyte_t* g = (gbyte_t*)q; asm volatile("" : "+s"(g)); return (unsigned char*)g; }
#ifndef PH
#define PH 0xFFFF
#endif
#ifndef PROBE
#define PROBE 0
#endif
#define WSP(T, off) ((T*)(ws + (off)))
__global__ void __launch_bounds__(512, 2) yoco_fwd(Params p) {
    extern __shared__ __attribute__((aligned(16))) unsigned char lds_raw[];
    LAS unsigned char* lds = (LAS unsigned char*)lds_raw;
    cg::grid_group grid = cg::this_grid();
    volatile LAS unsigned* bst = (volatile LAS unsigned*)(lds + 131072);
    if (threadIdx.x < 2) bst[threadIdx.x] = 0u;
    __syncthreads();
    XcdBarrier xbar = xcd_barrier_post((unsigned*)(p.ws + WS_BAR), bst);
    if (PH & 1) prologue(p, lds);
    grid.sync();
    if (PROBE == 2) { prologue(p, lds); xcd_barrier(xbar); }
    if (PROBE == 3) { for (int i = 0; i < 20; ++i) xcd_barrier(xbar); }
    for (int l = 0; l < 2; ++l) {
        for (int rep = 0; rep < (PROBE == 5 ? 2 : 1); ++rep) {
        if (PH & 2) { unsigned char* ws = fresh(p.ws); int cpm_ = -1; pg8::EpiConvFused E{WSP(float, WS_SSQH), WSP(bf16_t, WS_Z), WSP(bf16_t, WS_GB), WSP(bf16_t, WS_Y), p.in[4] + l * 3 * 1024, (LAS float*)(lds + 132096), cpm_};
            int k_ = 1024; asm volatile("" : "+s"(k_)); pg8::Gemm g_{(const bf16_t*)(ws + WS_HB), (const bf16_t*)(ws + WS_W + l * SZ_CONV + OW_WIN), T_, 3072, k_}; pg8::TripleOrder S_; S_.init((int)gridDim.x, (int)blockIdx.x);
            pg8::gemm_phase<pg8::EpiConvFused, pg8::TripleOrder, true, true>(lds, g_, S_, E); }
        xcd_barrier(xbar);
        }
        if (PH & 8) { unsigned char* ws = fresh(p.ws); conv_fix_rows(WSP(bf16_t, WS_Z), WSP(bf16_t, WS_GB), p.in[4] + l * 3 * 1024, WSP(bf16_t, WS_Y), T_, 1024); if (l == 0) { pg8::EpiResid<true> E{p.in[0], WSP(bf16_t, WS_HB), WSP(float, WS_SSQH)}; GEMM_PHASE(pg8::EpiResid<true>, ws + WS_Y, ws + WS_W + l * SZ_CONV + OW_WOUT, T_, 1024, 1024, E); }
            else { pg8::EpiResid<false> E{nullptr, WSP(bf16_t, WS_HB), WSP(float, WS_SSQH)}; GEMM_PHASE(pg8::EpiResid<false>, ws + WS_Y, ws + WS_W + l * SZ_CONV + OW_WOUT, T_, 1024, 1024, E); } }
        xcd_barrier(xbar);
        for (int rep = 0; rep < (PROBE == 4 ? 2 : 1); ++rep) {
        if (PH & 16) { unsigned char* ws = fresh(p.ws); int cpm_ = -1; pg8::EpiSwiglu E{WSP(float, WS_SSQH), WSP(bf16_t, WS_ACT), (LAS float*)(lds + 132096), cpm_};
            GEMM_PHASE(pg8::EpiSwiglu, ws + WS_HB, ws + WS_W + l * SZ_CONV + OW_CW13, T_, 5632, 1024, E); }
        xcd_barrier(xbar);
        }
        if (PH & 8) { unsigned char* ws = fresh(p.ws); pg8::EpiResid<false> E{nullptr, WSP(bf16_t, WS_HB), WSP(float, WS_SSQH)};
            GEMM_PHASE(pg8::EpiResid<false>, ws + WS_ACT, ws + WS_W + l * SZ_CONV + OW_CW2, T_, 1024, 2816, E); }
        xcd_barrier(xbar);
    }
    for (int j = 0; j < 2; ++j) {
        if (PH & 32) { unsigned char* ws = fresh(p.ws); pg8::EpiDKVQ E{WSP(float, WS_SSQH), j == 0 ? 0 : 2, WSP(bf16_t, WS_CLAT), WSP(float, WS_SSQL), WSP(bf16_t, WS_KPE), WSP(float, WS_CS), WSP(bf16_t, WS_CQ), WSP(float, WS_SSQQ)};
            GEMM_PHASE(pg8::EpiDKVQ, ws + WS_HB, ws + WS_W + (j == 0 ? OW_DKVQ : OW_WDQ1), T_, (j == 0 ? 1024 : 512), 1024, E); }
        xcd_barrier(xbar);
        if (j == 0) {
            if (PH & 64) { unsigned char* ws = fresh(p.ws); pg8::EpiRowScale E{WSP(float, WS_SSQL), WSP(bf16_t, WS_KN)}; GEMM_PHASE(pg8::EpiRowScale, ws + WS_CLAT, ws + WS_W + OW_WK, T_, 1024, 256, E); }
            if (PH & 128) { unsigned char* ws = fresh(p.ws); pg8::EpiVT E{WSP(float, WS_SSQL), WSP(bf16_t, WS_VT)}; GEMM_PHASE(pg8::EpiVT, ws + WS_W + OW_WVT, ws + WS_CLAT, 1024, T_, 256, E); }
        }
        if (PH & 256) { unsigned char* ws = fresh(p.ws); pg8::EpiQ E{WSP(float, WS_SSQQ), WSP(float, WS_CS), WSP(bf16_t, WS_Q), QSCALE}; GEMM_PHASE(pg8::EpiQ, ws + WS_CQ, ws + WS_W + OW_WUQ + j * SZ_WUQ, T_, 1536, 384, E); }
        xcd_barrier(xbar);
        if (PROBE == 1) { unsigned char* ws = fresh(p.ws); att::attn_phase(WSP(bf16_t, WS_Q), WSP(bf16_t, WS_KN), WSP(bf16_t, WS_KPE), WSP(bf16_t, WS_VT), WSP(bf16_t, WS_ATT), lds); xcd_barrier(xbar); }
        if (PH & 512) { unsigned char* ws = fresh(p.ws); att::attn_phase(WSP(bf16_t, WS_Q), WSP(bf16_t, WS_KN), WSP(bf16_t, WS_KPE), WSP(bf16_t, WS_VT), WSP(bf16_t, WS_ATT), lds); }
        xcd_barrier(xbar);
        if (PH & 8) { unsigned char* ws = fresh(p.ws); pg8::EpiResid<false> E{nullptr, WSP(bf16_t, WS_HB), WSP(float, WS_SSQH)};
            GEMM_PHASE(pg8::EpiResid<false>, ws + WS_ATT, ws + WS_W + OW_WO + j * SZ_WSQ, T_, 1024, 1024, E); }
        xcd_barrier(xbar);
        if (PH & 16) { unsigned char* ws = fresh(p.ws); int cpm_ = -1; pg8::EpiSwiglu E{WSP(float, WS_SSQH), WSP(bf16_t, WS_ACT), (LAS float*)(lds + 132096), cpm_};
            GEMM_PHASE(pg8::EpiSwiglu, ws + WS_HB, ws + WS_W + OW_MW13 + j * SZ_W13, T_, 5632, 1024, E); }
        xcd_barrier(xbar);
        if (PH & 8) { unsigned char* ws = fresh(p.ws); pg8::EpiResid<false> E{nullptr, WSP(bf16_t, WS_HB), WSP(float, WS_SSQH)};
            GEMM_PHASE(pg8::EpiResid<false>, ws + WS_ACT, ws + WS_W + OW_MW2 + j * SZ_W2, T_, 1024, 2816, E); }
        xcd_barrier(xbar);
    }
    if (PH & 1024) { unsigned char* ws = fresh(p.ws); final_norm(p.out, WSP(bf16_t, WS_HB), WSP(float, WS_SSQH), p.in[21]); }
}

extern "C" void kernel_launch(void* const* d_in, const int* in_sizes, int n_in, void* d_out, int out_size, void* d_ws, size_t ws_size, hipStream_t stream) {
    static int grid = 0;
    if (grid == 0) {
        if (n_in != 22 || out_size != T_ * DM || ws_size < WS_END) { fprintf(stderr, "kernel_launch: unexpected shapes (n_in %d, out %d, ws %zu)\n", n_in, out_size, ws_size); grid = -1; return; }
        int dev = 0, cus = 0, per_cu = 0;
        (void)hipGetDevice(&dev); (void)hipDeviceGetAttribute(&cus, hipDeviceAttributeMultiprocessorCount, dev);
        if (hipFuncSetAttribute((const void*)yoco_fwd, hipFuncAttributeMaxDynamicSharedMemorySize, LDS_BYTES) != hipSuccess) { fprintf(stderr, "kernel_launch: hipFuncSetAttribute failed\n"); grid = -1; return; }
        if (hipOccupancyMaxActiveBlocksPerMultiprocessor(&per_cu, (const void*)yoco_fwd, 512, LDS_BYTES) != hipSuccess || per_cu < 1) { fprintf(stderr, "kernel_launch: occupancy query gave %d\n", per_cu); per_cu = 1; }
        (void)hipGetLastError();
        grid = cus * 1;
        if (grid <= 0) grid = 256;
    }
    if (grid < 0) return;
    if (hipMemsetAsync((char*)d_ws + WS_BAR, 0, BAR_BYTES, stream) != hipSuccess) { fprintf(stderr, "kernel_launch: memset of barrier words failed\n"); return; }
    Params p{};
    for (int i = 0; i < 22; ++i) p.in[i] = (const float*)d_in[i];
    p.out = (float*)d_out; p.ws = (unsigned char*)d_ws;
    void* args[] = {&p};
    hipError_t e = hipLaunchCooperativeKernel((const void*)yoco_fwd, dim3(grid), dim3(512), args, LDS_BYTES, stream);
    if (e != hipSuccess) fprintf(stderr, "kernel_launch: cooperative launch failed: %s (grid %d)\n", hipGetErrorString(e), grid);
}
```

```cpp
#include <hip/hip_runtime.h>
#include <hip/hip_cooperative_groups.h>
#include <cstdio>
#include <cstdint>
namespace cg = cooperative_groups;

constexpr int T_ = 32768, DM = 1024, SEQ = 2048, NBATCH = 16, NHEAD = 8, DFF = 2816;
constexpr float RMS_EPS = 1e-6f;
constexpr float QSCALE = 0.07216878364870322f * 1.4426950408889634f;

namespace pg8 {
#define PG8_LAS __attribute__((address_space(3)))
typedef unsigned short bf16_t;
typedef short bf16x8 __attribute__((ext_vector_type(8)));
typedef float f32x4 __attribute__((ext_vector_type(4)));
typedef unsigned u32x4 __attribute__((ext_vector_type(4)));
constexpr int BM = 256, BK = 64, HALF = 128, HTB = HALF * BK * 2  , STAGE_BYTES = 8 * HTB, NXCD = 8, WGM = 8;

__host__ __device__ __forceinline__ int lds_byte(int r, int c) { const int st = (r >> 4) * 2 + (c >> 5), rr = r & 15, cc = c & 31, ob = rr * 64 + cc * 2; return st * 1024 + (ob ^ (((ob >> 9) & 1) << 5)); }
__host__ __device__ __forceinline__ void stage_rc(int b, int& R, int& C) { const int st = b / 1024, sb = b % 1024, swz = sb ^ (((sb >> 9) & 1) << 5); R = (st >> 1) * 16 + swz / 64; C = (st & 1) * 32 + (swz % 64) / 2; }
__host__ __device__ __forceinline__ int perm32(int rho) { const int n = rho >> 4, i = rho & 15; return 8 * (i >> 2) + 4 * n + (i & 3); }

struct Unit { int pm, pn; };
struct Gemm { const bf16_t* A; const bf16_t* Bt; int M, N, K; };

struct StaticOrder {
    int nM, nN, nwg, G, c;
    __host__ __device__ void init(int M, int N, int G_, int c_) { nM = M / BM; nN = N / BM; nwg = nM * nN; G = G_; c = c_; }
    __host__ __device__ bool next(int i, Unit& u) const {
        const long L = (long)i * G + c; if (L >= nwg) return false;
        int wgid = (int)L; { const int q = nwg / NXCD, r = nwg % NXCD, xcd = wgid % NXCD, off = wgid / NXCD; wgid = (xcd < r ? xcd * (q + 1) : r * (q + 1) + (xcd - r) * q) + off; }
        const int nig = WGM * nN, gid = wgid / nig, fm = gid * WGM, gsz = (nM - fm) < WGM ? (nM - fm) : WGM;
        u.pm = fm + ((wgid % nig) % gsz); u.pn = (wgid % nig) / gsz; return true;
    }
    __device__ __forceinline__ void a_ready(const Unit&) const {}
    __device__ __forceinline__ void done(const Unit&) const {}
};
typedef float f32x2_t __attribute__((ext_vector_type(2))); typedef __bf16 bf16x2_t __attribute__((ext_vector_type(2)));
typedef unsigned u32x2 __attribute__((ext_vector_type(2)));
__device__ __forceinline__ unsigned pk_bf16(float lo, float hi) { f32x2_t v = {lo, hi}; bf16x2_t b = __builtin_convertvector(v, bf16x2_t); return __builtin_bit_cast(unsigned, b); }
__device__ __forceinline__ u32x4 pk8(const f32x4 a, const f32x4 b) { u32x4 w; w.x = pk_bf16(a[0], a[1]); w.y = pk_bf16(a[2], a[3]); w.z = pk_bf16(b[0], b[1]); w.w = pk_bf16(b[2], b[3]); return w; }
__device__ __forceinline__ float dot4(const f32x4 a) { return (a[0] * a[0] + a[1] * a[1]) + (a[2] * a[2] + a[3] * a[3]); }
template <int NS> __device__ __forceinline__ float rstd_of(const float* part, int row, float invn) {
    float s = 0.f;
#pragma unroll
    for (int i = 0; i < NS / 4; ++i) { const f32x4 v = *(const f32x4*)(part + (size_t)row * NS + 4 * i); s += (v[0] + v[1]) + (v[2] + v[3]); }
    return __builtin_amdgcn_rsqf(s * invn + 1e-6f);
}
typedef const f32x4 (&AccRef)[2][2][4][2];
template <int NS> __device__ __forceinline__ void wave_rstd(const float* part, int pm, int wr, int lane, float invn, float (&r)[2][4]) {
    constexpr int QPR = NS / 4, RPL = 64 / QPR, NL = 128 / RPL;
    asm volatile("" : "+v"(lane));
    float t[NL];
#pragma unroll
    for (int i = 0; i < NL; ++i) { const int rl = lane / QPR + RPL * i, grow = pm * BM + HALF * (rl >> 6) + 64 * wr + (rl & 63);
        const f32x4 v = *(const f32x4*)(part + (size_t)grow * NS + 4 * (lane % QPR)); float sm = (v[0] + v[1]) + (v[2] + v[3]);
#pragma unroll
        for (int o = 1; o < QPR; o <<= 1) sm += __shfl_xor(sm, o);
        t[i] = __builtin_amdgcn_rsqf(sm * invn + 1e-6f); }
    const int fr = lane & 15;
#pragma unroll
    for (int ai = 0; ai < 2; ++ai)
#pragma unroll
        for (int m = 0; m < 4; ++m) { const int rl0 = 64 * ai + 16 * m; r[ai][m] = __shfl(t[rl0 / RPL], ((rl0 % RPL) + fr) * QPR); }
}


struct EpiConvIn {
    static constexpr bool PERM = true, AFTER_DRAIN = false;
    const float* ssq; bf16_t* Z; bf16_t* GB;
    __device__ __forceinline__ void operator()(AccRef acc, const Unit& u, int wr, int wc, int fr, int fq) const {
        const int row0 = u.pm * BM + wr * 64 + fr; float rs[2][4]; wave_rstd<16>(ssq, u.pm, wr, fq * 16 + fr, 1.0f / 1024.0f, rs);
#pragma unroll
        for (int ai = 0; ai < 2; ++ai)
#pragma unroll
            for (int m = 0; m < 4; ++m) { const int row = row0 + ai * HALF + m * 16; const float r = rs[ai][m];
                if (u.pn < 8) { const float r2 = r * r; const f32x4 z0 = acc[ai][0][m][0] * acc[ai][1][m][0] * r2, z1 = acc[ai][0][m][1] * acc[ai][1][m][1] * r2;
                    *(u32x4*)(Z + (size_t)row * 1024 + u.pn * 128 + wc * 32 + 8 * fq) = pk8(z0, z1); }
                else {
#pragma unroll
                    for (int bj = 0; bj < 2; ++bj) *(u32x4*)(GB + (size_t)row * 1024 + (u.pn - 8) * 256 + bj * HALF + wc * 32 + 8 * fq) = pk8(acc[ai][bj][m][0] * r, acc[ai][bj][m][1] * r); } }
    }
};
struct TripleOrder {
    int G, c;
    __host__ __device__ void init(int G_, int c_) { G = G_; c = c_; }
    __host__ __device__ bool next(int i, Unit& u) const {
        const int tr = i / 3, j = i - 3 * tr, tidx = tr * G + c; if (tidx >= 512) return false;
        const int w = (tidx & 7) * 64 + (tidx >> 3);
        u.pm = w >> 2; const int q = w & 3; u.pn = (j == 2) ? 8 + q : 2 * q + j; return true;
    }
    __device__ __forceinline__ void a_ready(const Unit&) const {}
    __device__ __forceinline__ void done(const Unit&) const {}
};
__device__ __forceinline__ void unpack8(const u32x4 v, f32x4& a, f32x4& b) {
    a = (f32x4){__uint_as_float(v.x << 16), __uint_as_float(v.x & 0xffff0000u), __uint_as_float(v.y << 16), __uint_as_float(v.y & 0xffff0000u)};
    b = (f32x4){__uint_as_float(v.z << 16), __uint_as_float(v.z & 0xffff0000u), __uint_as_float(v.w << 16), __uint_as_float(v.w & 0xffff0000u)};
}
struct EpiConvFused {
    static constexpr bool PERM = true, AFTER_DRAIN = false;
    const float* ssq; bf16_t* Z; bf16_t* GB; bf16_t* Y; const float* cw; PG8_LAS float* rcache; int& cached_pm;
    __device__ __forceinline__ void operator()(AccRef acc, const Unit& u, int wr, int wc, int fr, int fq) const {
        const int row0 = u.pm * BM + wr * 64 + fr; PG8_LAS float* rc = rcache + (wr * 4 + wc) * 128 + fr;
        if (u.pm != cached_pm) { float t[2][4]; wave_rstd<16>(ssq, u.pm, wr, fq * 16 + fr, 1.0f / 1024.0f, t);
            if (fq == 0) {
#pragma unroll
                for (int ai = 0; ai < 2; ++ai)
#pragma unroll
                    for (int m = 0; m < 4; ++m) rc[ai * 64 + m * 16] = t[ai][m]; }
            cached_pm = u.pm; }
        if (u.pn < 8) {
            const int col = u.pn * 128 + wc * 32 + 8 * fq;
#pragma unroll
            for (int ai = 0; ai < 2; ++ai)
#pragma unroll
                for (int m = 0; m < 4; ++m) { const int row = row0 + ai * HALF + m * 16; const float r1 = rc[ai * 64 + m * 16], r2 = r1 * r1;
                    *(u32x4*)(Z + (size_t)row * 1024 + col) = pk8(acc[ai][0][m][0] * acc[ai][1][m][0] * r2, acc[ai][0][m][1] * acc[ai][1][m][1] * r2); }
        } else {
            const int q = u.pn - 8;
#pragma unroll
            for (int bj = 0; bj < 2; ++bj) { const int col = q * 256 + bj * HALF + wc * 32 + 8 * fq;
                const f32x4 w0a = *(const f32x4*)(cw + col), w0b = *(const f32x4*)(cw + col + 4), w1a = *(const f32x4*)(cw + 1024 + col), w1b = *(const f32x4*)(cw + 1024 + col + 4),
                            w2a = *(const f32x4*)(cw + 2048 + col), w2b = *(const f32x4*)(cw + 2048 + col + 4);
#pragma unroll
                for (int ai = 0; ai < 2; ++ai)
#pragma unroll
                    for (int mh = 0; mh < 2; ++mh) { u32x4 zq[2][3];
#pragma unroll
                        for (int mm = 0; mm < 2; ++mm) { const int row = row0 + ai * HALF + (2 * mh + mm) * 16; const unsigned bo = (unsigned)(row * 1024 + col) * 2u; const bool ok = (row & 255) >= 2;
                            zq[mm][0] = *(const u32x4*)((const char*)Z + bo); zq[mm][1] = *(const u32x4*)((const char*)Z + (ok ? bo - 2048u : bo)); zq[mm][2] = *(const u32x4*)((const char*)Z + (ok ? bo - 4096u : bo)); }
                        asm volatile("" ::: "memory");
#pragma unroll
                        for (int mm = 0; mm < 2; ++mm) { const int m = 2 * mh + mm, row = row0 + ai * HALF + m * 16; const float r = rc[ai * 64 + m * 16]; const unsigned bo = (unsigned)(row * 1024 + col) * 2u;
                            const f32x4 ga = acc[ai][bj][m][0] * r, gb = acc[ai][bj][m][1] * r;
                            if ((row & 255) < 2) *(u32x4*)((char*)GB + bo) = pk8(ga, gb);
                            else { f32x4 z0a, z0b, z1a, z1b, z2a, z2b; unpack8(zq[mm][0], z0a, z0b); unpack8(zq[mm][1], z1a, z1b); unpack8(zq[mm][2], z2a, z2b);
                                *(u32x4*)((char*)Y + bo) = pk8(ga * (w0a * z2a + w1a * z1a + w2a * z0a), gb * (w0b * z2b + w1b * z1b + w2b * z0b)); } } } }
        }
    }
};
template <bool F32BASE> struct EpiResid {
    static constexpr bool PERM = true, AFTER_DRAIN = false;
    const float* xbase; bf16_t* hb; float* ssq;
    __device__ __forceinline__ void operator()(AccRef acc, const Unit& u, int wr, int wc, int fr, int fq) const {
        const int row0 = u.pm * BM + wr * 64 + fr, col0 = u.pn * BM + wc * 32 + 8 * fq;
        if (F32BASE) {
#pragma unroll
            for (int ai = 0; ai < 2; ++ai)
#pragma unroll
                for (int mh = 0; mh < 2; ++mh) { f32x4 b[2][2][2];
#pragma unroll
                    for (int mm = 0; mm < 2; ++mm)
#pragma unroll
                        for (int bj = 0; bj < 2; ++bj) { const size_t off = (size_t)(row0 + ai * HALF + (2 * mh + mm) * 16) * 1024 + col0 + bj * HALF; b[mm][bj][0] = *(const f32x4*)(xbase + off); b[mm][bj][1] = *(const f32x4*)(xbase + off + 4); }
                    asm volatile("" ::: "memory");
#pragma unroll
                    for (int mm = 0; mm < 2; ++mm) { const int m = 2 * mh + mm, row = row0 + ai * HALF + m * 16; float s = 0.f;
#pragma unroll
                        for (int bj = 0; bj < 2; ++bj) { const size_t off = (size_t)row * 1024 + col0 + bj * HALF; const f32x4 o0 = b[mm][bj][0] + acc[ai][bj][m][0], o1 = b[mm][bj][1] + acc[ai][bj][m][1];
                            *(u32x4*)(hb + off) = pk8(o0, o1); s += dot4(o0) + dot4(o1); }
                        s += __shfl_xor(s, 16); s += __shfl_xor(s, 32);
                        if (fq == 0) ssq[(size_t)row * 16 + u.pn * 4 + wc] = s; } }
        } else {
#pragma unroll
            for (int ai = 0; ai < 2; ++ai) { u32x4 old[4][2];
#pragma unroll
                for (int m = 0; m < 4; ++m)
#pragma unroll
                    for (int bj = 0; bj < 2; ++bj) old[m][bj] = *(const u32x4*)(hb + (size_t)(row0 + ai * HALF + m * 16) * 1024 + col0 + bj * HALF);
                asm volatile("" ::: "memory");
#pragma unroll
                for (int m = 0; m < 4; ++m) { const int row = row0 + ai * HALF + m * 16; float s = 0.f;
#pragma unroll
                    for (int bj = 0; bj < 2; ++bj) { const size_t off = (size_t)row * 1024 + col0 + bj * HALF; f32x4 b0, b1; unpack8(old[m][bj], b0, b1);
                        const f32x4 o0 = b0 + acc[ai][bj][m][0], o1 = b1 + acc[ai][bj][m][1];
                        *(u32x4*)(hb + off) = pk8(o0, o1); s += dot4(o0) + dot4(o1); }
                    s += __shfl_xor(s, 16); s += __shfl_xor(s, 32);
                    if (fq == 0) ssq[(size_t)row * 16 + u.pn * 4 + wc] = s; } }
        }
    }
};
struct EpiSwiglu {
    static constexpr bool PERM = true, AFTER_DRAIN = false;
    const float* ssq; bf16_t* ACT; PG8_LAS float* rcache; int& cached_pm;
    __device__ __forceinline__ void operator()(AccRef acc, const Unit& u, int wr, int wc, int fr, int fq) const {
        const int row0 = u.pm * BM + wr * 64 + fr; PG8_LAS float* rc = rcache + (wr * 4 + wc) * 128 + fr;
        if (u.pm != cached_pm) { float t[2][4]; wave_rstd<16>(ssq, u.pm, wr, fq * 16 + fr, 1.0f / 1024.0f, t);
            if (fq == 0) {
#pragma unroll
                for (int ai = 0; ai < 2; ++ai)
#pragma unroll
                    for (int m = 0; m < 4; ++m) { const float r_ = t[ai][m]; rc[ai * 64 + m * 16] = -1.4426950408889634f * r_; rc[1024 + ai * 64 + m * 16] = __builtin_amdgcn_rcpf(r_ * r_); } }
            cached_pm = u.pm; }
        float rs[2][4], rq[2][4];
#pragma unroll
        for (int ai = 0; ai < 2; ++ai)
#pragma unroll
            for (int m = 0; m < 4; ++m) { rs[ai][m] = rc[ai * 64 + m * 16]; rq[ai][m] = rc[1024 + ai * 64 + m * 16]; }
#pragma unroll
        for (int ai = 0; ai < 2; ++ai)
#pragma unroll
            for (int m = 0; m < 4; ++m) { const int row = row0 + ai * HALF + m * 16; const float c = rs[ai][m], ir2 = rq[ai][m]; f32x4 a[2];
#pragma unroll
                for (int n = 0; n < 2; ++n) { const f32x4 x = acc[ai][0][m][n] * c, gu = acc[ai][0][m][n] * acc[ai][1][m][n];
#pragma unroll
                    for (int e = 0; e < 4; ++e) a[n][e] = gu[e] * __builtin_amdgcn_rcpf(__builtin_fmaf(__builtin_amdgcn_exp2f(x[e]), ir2, ir2)); }
                __builtin_nontemporal_store(pk8(a[0], a[1]), (u32x4*)((char*)ACT + (unsigned)((row * 2816 + u.pn * 128 + wc * 32 + 8 * fq) * 2))); }
    }
};
struct EpiDKVQ {
    static constexpr bool PERM = true, AFTER_DRAIN = false;
    const float* ssq; int pn_off; bf16_t* CLAT; float* ssql; bf16_t* KPE; const float* CS; bf16_t* CQ; float* ssqq;
    __device__ __forceinline__ void operator()(AccRef acc, const Unit& u, int wr, int wc, int fr, int fq) const {
        const int row0 = u.pm * BM + wr * 64 + fr, pn = u.pn + pn_off; float rs[2][4]; wave_rstd<16>(ssq, u.pm, wr, fq * 16 + fr, 1.0f / 1024.0f, rs);
#pragma unroll
        for (int ai = 0; ai < 2; ++ai)
#pragma unroll
            for (int m = 0; m < 4; ++m) { const int row = row0 + ai * HALF + m * 16; const float r = rs[ai][m];
                if (pn == 0) { float s = 0.f;
#pragma unroll
                    for (int bj = 0; bj < 2; ++bj) { const f32x4 a = acc[ai][bj][m][0] * r, b = acc[ai][bj][m][1] * r; s += dot4(a) + dot4(b);
                        *(u32x4*)(CLAT + (size_t)row * 256 + bj * HALF + wc * 32 + 8 * fq) = pk8(a, b); }
                    s += __shfl_xor(s, 16); s += __shfl_xor(s, 32);
                    if (fq == 0) ssql[(size_t)row * 4 + wc] = s;
                } else if (pn == 1) {
                    if (wc == 0) { f32x4 o1[2], o2[2];
#pragma unroll
                        for (int n = 0; n < 2; ++n) { const f32x4 x1 = acc[ai][0][m][n] * r, x2 = acc[ai][1][m][n] * r; const float* cs = CS + ((size_t)row * 32 + 8 * fq + 4 * n) * 2;
                            const f32x4 c01 = *(const f32x4*)cs, c23 = *(const f32x4*)(cs + 4);
                            const f32x4 co = {c01[0], c01[2], c23[0], c23[2]}, si = {c01[1], c01[3], c23[1], c23[3]};
                            o1[n] = x1 * co - x2 * si; o2[n] = x1 * si + x2 * co; }
                        *(u32x4*)(KPE + (size_t)row * 64 + 8 * fq) = pk8(o1[0], o1[1]); *(u32x4*)(KPE + (size_t)row * 64 + 32 + 8 * fq) = pk8(o2[0], o2[1]); }
                } else { const int t = pn - 2; float s = 0.f;
#pragma unroll
                    for (int bj = 0; bj < 2; ++bj) { const f32x4 a = acc[ai][bj][m][0] * r, b = acc[ai][bj][m][1] * r; s += dot4(a) + dot4(b);
                        if (t == 0 || bj == 0) *(u32x4*)(CQ + (size_t)row * 384 + t * 256 + bj * HALF + wc * 32 + 8 * fq) = pk8(a, b); }
                    s += __shfl_xor(s, 16); s += __shfl_xor(s, 32);
                    if (fq == 0) ssqq[(size_t)row * 8 + t * 4 + wc] = s; } }
    }
};
struct EpiRowScale {
    static constexpr bool PERM = true, AFTER_DRAIN = false;
    const float* ssql; bf16_t* O;
    __device__ __forceinline__ void operator()(AccRef acc, const Unit& u, int wr, int wc, int fr, int fq) const {
        const int row0 = u.pm * BM + wr * 64 + fr;
#pragma unroll
        for (int ai = 0; ai < 2; ++ai)
#pragma unroll
            for (int m = 0; m < 4; ++m) { const int row = row0 + ai * HALF + m * 16; const float r = rstd_of<4>(ssql, row, 1.0f / 256.0f);
#pragma unroll
                for (int bj = 0; bj < 2; ++bj) *(u32x4*)(O + (size_t)row * 1024 + u.pn * BM + bj * HALF + wc * 32 + 8 * fq) = pk8(acc[ai][bj][m][0] * r, acc[ai][bj][m][1] * r); }
    }
};
struct EpiVT {
    static constexpr bool PERM = true, AFTER_DRAIN = false;
    const float* ssql; bf16_t* VT;
    __device__ __forceinline__ void operator()(AccRef acc, const Unit& u, int wr, int wc, int fr, int fq) const {
        const int row0 = u.pm * BM + wr * 64 + fr;
#pragma unroll
        for (int bj = 0; bj < 2; ++bj) { const int c0 = u.pn * BM + bj * HALF + wc * 32 + 8 * fq; f32x4 r0, r1;
#pragma unroll
            for (int e = 0; e < 4; ++e) { r0[e] = rstd_of<4>(ssql, c0 + e, 1.0f / 256.0f); r1[e] = rstd_of<4>(ssql, c0 + 4 + e, 1.0f / 256.0f); }
            const int b = c0 >> 11, s = c0 & 2047;
#pragma unroll
            for (int ai = 0; ai < 2; ++ai)
#pragma unroll
                for (int m = 0; m < 4; ++m) { const int row = row0 + ai * HALF + m * 16;
                    *(u32x4*)(VT + ((size_t)b * 1024 + row) * 2048 + s) = pk8(acc[ai][bj][m][0] * r0, acc[ai][bj][m][1] * r1); } }
    }
};
struct EpiQ {
    static constexpr bool PERM = true, AFTER_DRAIN = false;
    const float* ssqq; const float* CS; bf16_t* Q; float qscale;
    __device__ __forceinline__ void operator()(AccRef acc, const Unit& u, int wr, int wc, int fr, int fq) const {
        const int row0 = u.pm * BM + wr * 64 + fr; float rs[2][4]; wave_rstd<8>(ssqq, u.pm, wr, fq * 16 + fr, 1.0f / 384.0f, rs);
#pragma unroll
        for (int ai = 0; ai < 2; ++ai)
#pragma unroll
            for (int m = 0; m < 4; ++m) { const int row = row0 + ai * HALF + m * 16; const float r = rs[ai][m] * qscale;
                if (u.pn < 4) {
#pragma unroll
                    for (int bj = 0; bj < 2; ++bj) *(u32x4*)(Q + (size_t)row * 1536 + (2 * u.pn + bj) * 192 + wc * 32 + 8 * fq) = pk8(acc[ai][bj][m][0] * r, acc[ai][bj][m][1] * r);
                } else { f32x4 o1[2], o2[2];
#pragma unroll
                    for (int n = 0; n < 2; ++n) { const f32x4 x1 = acc[ai][0][m][n] * r, x2 = acc[ai][1][m][n] * r; const float* cs = CS + ((size_t)row * 32 + 8 * fq + 4 * n) * 2;
                        const f32x4 c01 = *(const f32x4*)cs, c23 = *(const f32x4*)(cs + 4);
                        const f32x4 co = {c01[0], c01[2], c23[0], c23[2]}, si = {c01[1], c01[3], c23[1], c23[3]};
                        o1[n] = x1 * co - x2 * si; o2[n] = x1 * si + x2 * co; }
                    bf16_t* qp = Q + (size_t)row * 1536 + (4 * (u.pn - 4) + wc) * 192 + 128 + 8 * fq;
                    *(u32x4*)qp = pk8(o1[0], o1[1]); *(u32x4*)(qp + 32) = pk8(o2[0], o2[1]); } }
    }
};

template <class Epi, class Sched, bool ALIGN_EPI = false, bool SP2 = false>
__device__ __forceinline__ void gemm_phase(PG8_LAS unsigned char* lds, const Gemm g, const Sched& S, const Epi& E) {
    int tid_ = threadIdx.x; asm volatile("" : "+v"(tid_));
    const int tid = tid_, wid = __builtin_amdgcn_readfirstlane(tid >> 6), lane = tid & 63, wr = wid >> 2, wc = wid & 3, fr = lane & 15, fq = lane >> 4;
    const int K = g.K, nt = K / BK;
    unsigned voffA[2], voffB[2];
#pragma unroll
    for (int i = 0; i < 2; ++i) { int R, C; stage_rc(tid * 16 + i * 8192, R, C); const int Rb = Epi::PERM ? ((R & ~31) + perm32(R & 31)) : R;
        voffA[i] = (unsigned)(R * K + C) * 2u; voffB[i] = (unsigned)(Rb * K + C) * 2u; }
    const size_t kstep = (size_t)(BK * 2);
    const size_t hstep = (size_t)HALF * K * 2;
    const size_t tstep = 2 * hstep;
    const unsigned ldsw = (unsigned)wid * 1024u;
    const int aoff = lds_byte(wr * 64 + fr, fq * 8), boff = lds_byte(wc * 32 + fr, fq * 8);
#define PG8_SA(b, h) (((b) * 2 + (h)) * HTB)
#define PG8_SB(b, h) ((4 + (b) * 2 + (h)) * HTB)
#define PG8_STAGE(bufoff, gbase, voff) do { _Pragma("unroll") for (int _i = 0; _i < 2; ++_i) \
        __builtin_amdgcn_global_load_lds((const unsigned*)((const char*)(gbase) + (voff)[_i]), (PG8_LAS unsigned*)(lds + (bufoff) + ldsw + _i * 8192), 16, 0, 0); } while (0)
#define PG8_LDA(dst, b, h) do { _Pragma("unroll") for (int m = 0; m < 4; ++m) _Pragma("unroll") for (int k = 0; k < 2; ++k) dst[m][k] = *(const PG8_LAS bf16x8*)(lds + PG8_SA(b, h) + aoff + m * 2048 + k * 1024); } while (0)
#define PG8_LDB(dst, b, h) do { _Pragma("unroll") for (int n = 0; n < 2; ++n) _Pragma("unroll") for (int k = 0; k < 2; ++k) dst[n][k] = *(const PG8_LAS bf16x8*)(lds + PG8_SB(b, h) + boff + n * 2048 + k * 1024); } while (0)
#define PG8_MMA(ai, bj, At, Bt) do { __builtin_amdgcn_s_setprio(1); _Pragma("unroll") for (int m = 0; m < 4; ++m) _Pragma("unroll") for (int n = 0; n < 2; ++n) _Pragma("unroll") for (int k = 0; k < 2; ++k) \
        acc[ai][bj][m][n] = __builtin_amdgcn_mfma_f32_16x16x32_bf16(Bt[n][k], At[m][k], acc[ai][bj][m][n], 0, 0, 0); __builtin_amdgcn_s_setprio(0); } while (0)
#define PG8_WAIT_V(n) asm volatile("s_waitcnt vmcnt(" #n ")" ::: "memory")
#define PG8_WAIT_L(n) asm volatile("s_waitcnt lgkmcnt(" #n ")" ::: "memory")
#define PG8_BAR __builtin_amdgcn_s_barrier()
#define PG8_SCHED __builtin_amdgcn_sched_barrier(0)
    Unit cur, nxt; int ui = 0;
    if (!S.next(0, cur)) return;
    f32x4 acc[2][2][4][2];
#pragma unroll
    for (int a = 0; a < 2; ++a)
#pragma unroll
        for (int b = 0; b < 2; ++b)
#pragma unroll
            for (int m = 0; m < 4; ++m)
#pragma unroll
                for (int n = 0; n < 2; ++n) acc[a][b][m][n] = (f32x4){0.f, 0.f, 0.f, 0.f};
    bf16x8 At[4][2], B0[2][2], B1[2][2];
    const char* cA = (const char*)g.A + (size_t)cur.pm * tstep; const char* cB = (const char*)g.Bt + (size_t)cur.pn * tstep;
    S.a_ready(cur);
    if constexpr (SP2) {
        PG8_STAGE(PG8_SB(0, 0), cB, voffB); PG8_STAGE(PG8_SB(0, 1), cB + hstep, voffB); PG8_STAGE(PG8_SA(0, 0), cA, voffA); PG8_STAGE(PG8_SA(0, 1), cA + hstep, voffA);
        if (wr == 1) PG8_BAR;
        PG8_WAIT_V(2); PG8_BAR;
        PG8_STAGE(PG8_SB(1, 0), cB + kstep, voffB); PG8_STAGE(PG8_SA(1, 0), cA + kstep, voffA); PG8_STAGE(PG8_SB(1, 1), cB + hstep + kstep, voffB);
        PG8_WAIT_V(6); PG8_BAR;
    } else {
        PG8_STAGE(PG8_SB(0, 0), cB, voffB); PG8_STAGE(PG8_SA(0, 0), cA, voffA); PG8_STAGE(PG8_SB(0, 1), cB + hstep, voffB); PG8_STAGE(PG8_SA(0, 1), cA + hstep, voffA);
        if (wr == 1) PG8_BAR;
        PG8_WAIT_V(4); PG8_BAR;
        PG8_STAGE(PG8_SB(1, 0), cB + kstep, voffB); PG8_STAGE(PG8_SA(1, 0), cA + kstep, voffA); PG8_STAGE(PG8_SB(1, 1), cB + hstep + kstep, voffB);
        PG8_WAIT_V(6); PG8_BAR;
    }
    for (;;) {
        const bool has_next = S.next(ui + 1, nxt);
        const char* nA = has_next ? (const char*)g.A + (size_t)nxt.pm * tstep : cA; const char* nB = has_next ? (const char*)g.Bt + (size_t)nxt.pn * tstep : cB;
        for (int t = 0; t < nt; t += 2) {
            const bool last = (t == nt - 2);
            const char* a1 = cA + (size_t)(t + 1) * kstep;
            const char* a2 = last ? nA : cA + (size_t)(t + 2) * kstep; const char* b2 = last ? nB : cB + (size_t)(t + 2) * kstep;
            const char* a3 = a2 + kstep; const char* b3 = b2 + kstep;
            if (last && has_next) S.a_ready(nxt);
            if constexpr (SP2) {
            PG8_LDB(B0, 0, 0); PG8_LDB(B1, 0, 1); PG8_SCHED; PG8_LDA(At, 0, 0); PG8_STAGE(PG8_SA(1, 1), a1 + hstep, voffA);
            PG8_WAIT_V(8); PG8_WAIT_L(0); PG8_BAR; PG8_MMA(0, 0, At, B0); PG8_MMA(0, 1, At, B1); PG8_BAR; PG8_SCHED;
            PG8_LDA(At, 0, 1); PG8_STAGE(PG8_SB(0, 0), b2, voffB); PG8_STAGE(PG8_SB(0, 1), b2 + hstep, voffB); PG8_STAGE(PG8_SA(0, 0), a2, voffA);
            PG8_WAIT_V(8); PG8_WAIT_L(0); PG8_BAR; PG8_MMA(1, 0, At, B0); PG8_MMA(1, 1, At, B1); PG8_BAR; PG8_SCHED;
            PG8_LDB(B0, 1, 0); PG8_LDB(B1, 1, 1); PG8_SCHED; PG8_LDA(At, 1, 0); PG8_STAGE(PG8_SA(0, 1), a2 + hstep, voffA);
            PG8_WAIT_V(8); PG8_WAIT_L(0); PG8_BAR; PG8_MMA(0, 0, At, B0); PG8_MMA(0, 1, At, B1); PG8_BAR; PG8_SCHED;
            PG8_LDA(At, 1, 1); PG8_STAGE(PG8_SB(1, 0), b3, voffB); PG8_STAGE(PG8_SB(1, 1), b3 + hstep, voffB); PG8_STAGE(PG8_SA(1, 0), a3, voffA);
            PG8_WAIT_V(8); PG8_WAIT_L(0); PG8_BAR; PG8_MMA(1, 0, At, B0); PG8_MMA(1, 1, At, B1); PG8_BAR; PG8_SCHED;
            } else {
            PG8_LDB(B0, 0, 0); PG8_SCHED; PG8_LDA(At, 0, 0); PG8_STAGE(PG8_SA(1, 1), a1 + hstep, voffA);
            PG8_WAIT_L(8); PG8_BAR; PG8_WAIT_L(0); PG8_MMA(0, 0, At, B0); PG8_BAR; PG8_SCHED;
            PG8_LDB(B1, 0, 1); PG8_STAGE(PG8_SB(0, 0), b2, voffB);
            PG8_BAR; PG8_WAIT_L(0); PG8_MMA(0, 1, At, B1); PG8_BAR;
            PG8_LDA(At, 0, 1); PG8_STAGE(PG8_SA(0, 0), a2, voffA);
            PG8_BAR; PG8_WAIT_L(0); PG8_MMA(1, 0, At, B0); PG8_BAR; PG8_SCHED;
            PG8_STAGE(PG8_SB(0, 1), b2 + hstep, voffB);
            PG8_WAIT_V(6); PG8_BAR; PG8_MMA(1, 1, At, B1); PG8_BAR;
            PG8_LDB(B0, 1, 0); PG8_SCHED; PG8_LDA(At, 1, 0); PG8_STAGE(PG8_SA(0, 1), a2 + hstep, voffA);
            PG8_WAIT_L(8); PG8_BAR; PG8_WAIT_L(0); PG8_MMA(0, 0, At, B0); PG8_BAR; PG8_SCHED;
            PG8_LDB(B1, 1, 1); PG8_STAGE(PG8_SB(1, 0), b3, voffB);
            PG8_BAR; PG8_WAIT_L(0); PG8_MMA(0, 1, At, B1); PG8_BAR;
            PG8_LDA(At, 1, 1); PG8_STAGE(PG8_SA(1, 0), a3, voffA);
            PG8_BAR; PG8_WAIT_L(0); PG8_MMA(1, 0, At, B0); PG8_BAR; PG8_SCHED;
            PG8_STAGE(PG8_SB(1, 1), b3 + hstep, voffB);
            PG8_WAIT_V(6); PG8_BAR; PG8_MMA(1, 1, At, B1); PG8_BAR;
            }
        }
        if constexpr (ALIGN_EPI) { if (wr == 0) PG8_BAR; }
        if constexpr (!Epi::AFTER_DRAIN) { E(acc, cur, wr, wc, fr, fq); S.done(cur); }
        if (!has_next) break;
#pragma unroll
        for (int a = 0; a < 2; ++a)
#pragma unroll
            for (int b = 0; b < 2; ++b)
#pragma unroll
                for (int m = 0; m < 4; ++m)
#pragma unroll
                    for (int n = 0; n < 2; ++n) acc[a][b][m][n] = (f32x4){0.f, 0.f, 0.f, 0.f};
        cur = nxt; cA = nA; cB = nB; ++ui;
        if constexpr (ALIGN_EPI) { if (wr == 1) PG8_BAR; }
    }
    PG8_WAIT_V(0);
    if constexpr (!ALIGN_EPI) { if (wr == 0) PG8_BAR; }
    PG8_BAR;
    if constexpr (Epi::AFTER_DRAIN) { E.fused(acc, cur, wr, wc, fr, fq, lds, wid, lane); S.done(cur); }
#undef PG8_SA
#undef PG8_SB
#undef PG8_STAGE
#undef PG8_LDA
#undef PG8_LDB
#undef PG8_MMA
#undef PG8_WAIT_V
#undef PG8_WAIT_L
#undef PG8_BAR
#undef PG8_SCHED
}}

#define LAS __attribute__((address_space(3)))
typedef unsigned short bf16_t;
typedef short bf16x8 __attribute__((ext_vector_type(8)));
typedef float f32x4 __attribute__((ext_vector_type(4)));
typedef float f32x16 __attribute__((ext_vector_type(16)));
typedef unsigned u32x4 __attribute__((ext_vector_type(4)));
typedef unsigned u32x2 __attribute__((ext_vector_type(2)));
using pg8::pk_bf16; using pg8::pk8;

namespace att {
constexpr int KROW = 400, KTILE = 64 * KROW, VROW = 144, VTILE = 128 * VROW, BUF = KTILE + VTILE;
__device__ __forceinline__ int crow(int r, int hi) { return (r & 3) + 8 * (r >> 2) + 4 * hi; }
#define ATT_MFMA(a, b, c) __builtin_amdgcn_mfma_f32_32x32x16_bf16((a), (b), (c), 0, 0, 0)
#define ATT_SB() __builtin_amdgcn_sched_barrier(0)
__device__ __forceinline__ float max3f(float a, float b, float c) { float r; asm("v_max3_f32 %0, %1, %2, %3" : "=v"(r) : "v"(a), "v"(b), "v"(c)); return r; }
__device__ __forceinline__ void attn_unit(int b, int h, int qb, const bf16_t* __restrict__ Q, const bf16_t* __restrict__ KN, const bf16_t* __restrict__ KPE, const bf16_t* __restrict__ VT, bf16_t* __restrict__ O, LAS unsigned char* lds) {
    int tid_ = threadIdx.x; asm volatile("" : "+v"(tid_));
    const int tid = tid_, lane = tid & 63, wid = __builtin_amdgcn_readfirstlane(tid >> 6), q32 = lane & 31, hi = lane >> 5;
    const int q0 = qb * 256; const size_t tok0 = (size_t)b * SEQ;
    const int qrow = q0 + wid * 32 + q32;
    bf16x8 qf[12];
    { const bf16_t* qp = Q + (tok0 + qrow) * 1536 + h * 192 + hi * 8;
#pragma unroll
      for (int s = 0; s < 12; ++s) qf[s] = *(const bf16x8*)(qp + s * 16); }
    const char* kbase = (const char*)(KN + tok0 * 1024 + h * 128); const char* pbase = (const char*)(KPE + tok0 * 64); const char* vbase = (const char*)(VT + (size_t)(b * 8 + h) * 128 * 2048);
#define ATT_RETID() int t2_ = tid; asm volatile("" : "+v"(t2_)); const unsigned srow_ = (unsigned)t2_ >> 3, spart_ = (unsigned)t2_ & 7u
    const int NT = (q0 + 256) / 64;
    u32x4 rb0, rb1, rb2, rb3, rb4;
#define ATT_LOAD(t, R0, R1, R2, R3, R4) do { ATT_RETID(); const unsigned koff = srow_ * 2048 + spart_ * 16, poff = srow_ * 128 + spart_ * 16, voff = srow_ * 4096 + spart_ * 16; \
        const char* kb_ = kbase + (size_t)(t) * (64 * 2048); const char* pb_ = pbase + (size_t)(t) * (64 * 128); const char* vb_ = vbase + (size_t)(t) * 128; \
        R0 = *(const u32x4*)(kb_ + koff); R1 = *(const u32x4*)(kb_ + 128 + koff); R2 = *(const u32x4*)(pb_ + poff); R3 = *(const u32x4*)(vb_ + voff); R4 = *(const u32x4*)(vb_ + 64 * 4096 + voff); } while (0)
#define ATT_STORE(bo, R0, R1, R2, R3, R4) do { ATT_RETID(); const unsigned kdst = srow_ * KROW + spart_ * 16, vdst = KTILE + srow_ * VROW + (spart_ >> 1) * 32 + (spart_ & 1) * 8; LAS unsigned char* b_ = lds + (bo); \
        *(LAS u32x4*)(b_ + kdst) = R0; *(LAS u32x4*)(b_ + kdst + 128) = R1; *(LAS u32x4*)(b_ + kdst + 256) = R2; \
        *(LAS u32x2*)(b_ + vdst) = (u32x2){R3.x, R3.y}; *(LAS u32x2*)(b_ + vdst + 16) = (u32x2){R3.z, R3.w}; \
        *(LAS u32x2*)(b_ + vdst + 64 * VROW) = (u32x2){R4.x, R4.y}; *(LAS u32x2*)(b_ + vdst + 64 * VROW + 16) = (u32x2){R4.z, R4.w}; } while (0)
#define ATT_LOAD_B(t) ATT_LOAD(t, rb0, rb1, rb2, rb3, rb4)
#define ATT_STORE_B(bo) ATT_STORE(bo, rb0, rb1, rb2, rb3, rb4)
    f32x16 o[4];
#pragma unroll
    for (int d = 0; d < 4; ++d)
#pragma unroll
        for (int r = 0; r < 16; ++r) o[d][r] = 0.f;
    float mrun = 0.f, lrun = 0.f;
    f32x16 negm;
#pragma unroll
    for (int r = 0; r < 16; ++r) negm[r] = 0.f;
    ATT_LOAD_B(0); ATT_STORE_B(0); __syncthreads();
#define ATT_COMPUTE(t_) do { const int t = (t_); const int cur = (t & 1) * BUF, k0 = t * 64; \
        if (k0 <= q0 + wid * 32 + 31) { \
            f32x16 s0 = negm, s1 = negm; \
            const LAS unsigned char* kb = lds + cur + q32 * KROW + hi * 16; \
            bf16x8 ka[2][2]; \
            ATT_SB(); \
        _Pragma("unroll") \
            for (int st = 0; st < 2; ++st) { ka[st][0] = *(const LAS bf16x8*)(kb + st * 32); ka[st][1] = *(const LAS bf16x8*)(kb + 32 * KROW + st * 32); } \
            ATT_SB(); \
        _Pragma("unroll") \
            for (int st = 0; st < 12; ++st) { \
                s0 = ATT_MFMA(ka[st & 1][0], qf[st], s0); s1 = ATT_MFMA(ka[st & 1][1], qf[st], s1); \
                ATT_SB(); \
                if (st + 2 < 12) { ka[st & 1][0] = *(const LAS bf16x8*)(kb + (st + 2) * 32); ka[st & 1][1] = *(const LAS bf16x8*)(kb + 32 * KROW + (st + 2) * 32); ATT_SB(); } \
            } \
            asm volatile("s_nop 15\n\ts_nop 7" : "+v"(s0), "+v"(s1));     \
            if (k0 + 63 > q0 + wid * 32) { \
        _Pragma("unroll") \
                for (int r = 0; r < 16; ++r) { const int key = k0 + crow(r, hi); if (key > qrow) s0[r] = -INFINITY; if (key + 32 > qrow) s1[r] = -INFINITY; } \
            } \
            float mxa = max3f(s0[0], s0[1], s1[0]), mxb = max3f(s0[2], s0[3], s1[1]); mxa = max3f(mxa, s1[2], s1[3]); \
        _Pragma("unroll") \
            for (int r = 4; r < 16; r += 4) { mxa = max3f(mxa, s0[r], s0[r + 1]); mxb = max3f(mxb, s0[r + 2], s0[r + 3]); mxa = max3f(mxa, s1[r], s1[r + 1]); mxb = max3f(mxb, s1[r + 2], s1[r + 3]); } \
            float mx = max3f(mxa, mxb, mxb); \
            { auto rr = __builtin_amdgcn_permlane32_swap(__float_as_uint(mx), __float_as_uint(mx), false, false); mx = max3f(__uint_as_float(rr[0]), __uint_as_float(rr[1]), mx); } \
            if (t == 0 || __any(mx > 8.0f)) {        \
                const float dl = (t == 0) ? mx : fmaxf(mx, 0.f), alpha = (t == 0) ? 1.0f : __builtin_amdgcn_exp2f(-dl); mrun += dl; lrun *= alpha; \
        _Pragma("unroll") \
                for (int r = 0; r < 16; ++r) { s0[r] -= dl; s1[r] -= dl; negm[r] = -mrun; } \
        _Pragma("unroll") \
                for (int d = 0; d < 4; ++d) \
        _Pragma("unroll") \
                    for (int r = 0; r < 16; ++r) o[d][r] *= alpha; } \
            const LAS unsigned char* vb = lds + cur + KTILE + q32 * VROW + hi * 16; \
            bf16x8 va[2][4]; \
            ATT_SB(); \
        _Pragma("unroll") \
            for (int d = 0; d < 4; ++d) va[0][d] = *(const LAS bf16x8*)(vb + d * 32 * VROW); \
            ATT_SB(); \
              \
        _Pragma("unroll") \
            for (int r = 0; r < 16; ++r) s0[r] = __builtin_amdgcn_exp2f(s0[r]); \
            bf16x8 pk[4]; \
            { u32x4 w; \
              w.x = pk_bf16(s0[0], s0[1]); w.y = pk_bf16(s0[2], s0[3]); w.z = pk_bf16(s0[4], s0[5]); w.w = pk_bf16(s0[6], s0[7]); pk[0] = __builtin_bit_cast(bf16x8, w); \
              w.x = pk_bf16(s0[8], s0[9]); w.y = pk_bf16(s0[10], s0[11]); w.z = pk_bf16(s0[12], s0[13]); w.w = pk_bf16(s0[14], s0[15]); pk[1] = __builtin_bit_cast(bf16x8, w); } \
            ATT_SB(); \
        _Pragma("unroll") \
            for (int j = 0; j < 2; ++j) { \
        _Pragma("unroll") \
                for (int d = 0; d < 4; ++d) { \
                    va[(j + 1) & 1][d] = *(const LAS bf16x8*)(vb + d * 32 * VROW + (j + 1) * 32); \
                    o[d] = ATT_MFMA(va[j & 1][d], pk[j], o[d]); \
                    s1[(j * 4 + d) * 2] = __builtin_amdgcn_exp2f(s1[(j * 4 + d) * 2]); s1[(j * 4 + d) * 2 + 1] = __builtin_amdgcn_exp2f(s1[(j * 4 + d) * 2 + 1]); \
                    ATT_SB(); } } \
            { u32x4 w; \
              w.x = pk_bf16(s1[0], s1[1]); w.y = pk_bf16(s1[2], s1[3]); w.z = pk_bf16(s1[4], s1[5]); w.w = pk_bf16(s1[6], s1[7]); pk[2] = __builtin_bit_cast(bf16x8, w); \
              w.x = pk_bf16(s1[8], s1[9]); w.y = pk_bf16(s1[10], s1[11]); w.z = pk_bf16(s1[12], s1[13]); w.w = pk_bf16(s1[14], s1[15]); pk[3] = __builtin_bit_cast(bf16x8, w); } \
            ATT_SB(); \
            float ls = 0.f; \
        _Pragma("unroll") \
            for (int j = 2; j < 4; ++j) { \
        _Pragma("unroll") \
                for (int d = 0; d < 4; ++d) { \
                    if (j + 1 < 4) va[(j + 1) & 1][d] = *(const LAS bf16x8*)(vb + d * 32 * VROW + (j + 1) * 32); \
                    o[d] = ATT_MFMA(va[j & 1][d], pk[j], o[d]); \
                    { const int q4 = ((j - 2) * 4 + d) * 2; ls += (s0[q4] + s0[q4 + 1]) + (s1[q4] + s1[q4 + 1]); } \
                    ATT_SB(); } } \
            lrun += ls; \
        } \
    } while (0)
    for (int tt = 0; tt < NT; tt += 2) {
        ATT_LOAD_B(tt + 1);
        ATT_COMPUTE(tt);
        ATT_STORE_B(BUF);
        __syncthreads();
        ATT_LOAD_B(tt + 2 < NT ? tt + 2 : NT - 1);
        ATT_COMPUTE(tt + 1);
        if (tt + 2 < NT) ATT_STORE_B(0);
        __syncthreads();
    }
#undef ATT_COMPUTE
    const float ltot = lrun + __shfl_xor(lrun, 32), inv = 1.0f / ltot;
    bf16_t* op = O + (tok0 + qrow) * 1024 + h * 128 + 8 * hi;
#pragma unroll
    for (int d = 0; d < 4; ++d)
#pragma unroll
        for (int k = 0; k < 2; ++k) { const int g0 = 2 * k, g1 = 2 * k + 1;
            unsigned a0 = pk_bf16(o[d][4 * g0] * inv, o[d][4 * g0 + 1] * inv), a1 = pk_bf16(o[d][4 * g0 + 2] * inv, o[d][4 * g0 + 3] * inv);
            unsigned b0 = pk_bf16(o[d][4 * g1] * inv, o[d][4 * g1 + 1] * inv), b1 = pk_bf16(o[d][4 * g1 + 2] * inv, o[d][4 * g1 + 3] * inv);
            auto r0 = __builtin_amdgcn_permlane32_swap(a0, b0, false, false); auto r1 = __builtin_amdgcn_permlane32_swap(a1, b1, false, false);
            u32x4 w; w.x = r0[0]; w.y = r1[0]; w.z = r0[1]; w.w = r1[1];
            *(u32x4*)(op + d * 32 + k * 16) = w; }
#undef ATT_LOAD
#undef ATT_STORE
#undef ATT_RETID
#undef ATT_LOAD_B
#undef ATT_STORE_B
}
__device__ __forceinline__ void attn_phase(const bf16_t* Q, const bf16_t* KN, const bf16_t* KPE, const bf16_t* VT, bf16_t* O, LAS unsigned char* lds) {
    const int G = gridDim.x, bx = blockIdx.x, vcu = (G % 8 == 0) ? (bx % 8) * (G / 8) + bx / 8 : bx;
    for (int p = vcu; p < 512; p += G) { const int bh = p >> 2, s = p & 3;
        attn_unit(bh >> 3, bh & 7, 7 - s, Q, KN, KPE, VT, O, lds);
        attn_unit(bh >> 3, bh & 7, s, Q, KN, KPE, VT, O, lds); }
}
}

typedef unsigned v4u __attribute__((ext_vector_type(4)));
#define XB_TMO      128
#define XB_XCNT(j)  (256  + 64 * (j))
#define XB_XSUB(j)  (1280 + 64 * (j))
#define XB_XGEN(j)  (2304 + 64 * (j))
#define XB_TOP      3328
#define XB_TOPGEN   3392
#define XCD_BAR_WORDS 3456
#define XB_SPIN_CAP (1u << 18)

__device__ __forceinline__ unsigned xb_ld(unsigned* p)              { return __hip_atomic_load(p, __ATOMIC_RELAXED, __HIP_MEMORY_SCOPE_AGENT); }
__device__ __forceinline__ unsigned xb_add(unsigned* p, unsigned v) { return __hip_atomic_fetch_add(p, v, __ATOMIC_RELAXED, __HIP_MEMORY_SCOPE_AGENT); }
__device__ __forceinline__ unsigned xb_xcc_id() { return (unsigned)__builtin_amdgcn_s_getreg((3 << 11) | 20) & 0xFu; }
#define XB_SPIN(cond, bar) do { unsigned _sp = 0; while (cond) { __builtin_amdgcn_s_sleep(1); \
    if ((++_sp & 255u) == 0u) { if (xb_ld(&(bar)[XB_TMO])) break; if (_sp > XB_SPIN_CAP) { atomicAdd(&(bar)[XB_TMO], 1u); break; } } } } while (0)

struct XcdBarrier {
    unsigned* bar; unsigned x;
    volatile LAS unsigned* st;
};

__device__ __forceinline__ XcdBarrier xcd_barrier_post(unsigned* bar, volatile LAS unsigned* st) {
    XcdBarrier b; b.bar = bar; b.x = xb_xcc_id(); b.st = st;
    if (threadIdx.x == 0) (void)xb_add(&bar[XB_XCNT(b.x)], 1u);
    return b;
}
__device__ __forceinline__ void xcd_barrier_complete(unsigned* bar, unsigned x, unsigned& nloc, unsigned& nx) {
    const unsigned G = gridDim.x * gridDim.y * gridDim.z;
    unsigned sum, cnt, mine, sp = 0u;
    for (;;) {
        sum = 0u; cnt = 0u; mine = 0u;
#pragma unroll
        for (unsigned j = 0; j < 16; ++j) { const unsigned c = xb_ld(&bar[XB_XCNT(j)]); sum += c; cnt += (c > 0u) ? 1u : 0u; mine = (j == x) ? c : mine; }
        if (sum == G) break;
        __builtin_amdgcn_s_sleep(1);
        if ((++sp & 255u) == 0u) { if (xb_ld(&bar[XB_TMO])) break; if (sp > XB_SPIN_CAP) { atomicAdd(&bar[XB_TMO], 1u); break; } }
    }
    nloc = mine > 0u ? mine : 1u; nx = cnt > 0u ? cnt : 1u;
}

__device__ __forceinline__ void xcd_barrier(const XcdBarrier& b) {
    asm volatile("s_waitcnt vmcnt(0)" ::: "memory");
    __syncthreads();
    if (threadIdx.x == 0) {
        unsigned* bar = b.bar;
        __builtin_amdgcn_s_waitcnt(0);
        unsigned nloc = b.st[0], nx = b.st[1];
        if (nloc == 0u) { xcd_barrier_complete(bar, b.x, nloc, nx); b.st[0] = nloc; b.st[1] = nx; }
        const unsigned old = xb_add(&bar[XB_XSUB(b.x)], 1u);
        const unsigned gen = old / nloc;
        if (old + 1u == (gen + 1u) * nloc) {
            __builtin_amdgcn_fence(__ATOMIC_RELEASE, "agent");
            asm volatile("s_waitcnt vmcnt(0)" ::: "memory");
            const unsigned og = xb_add(&bar[XB_TOP], 1u);
            const unsigned tg = og / nx;
            if (og + 1u == (tg + 1u) * nx) xb_add(&bar[XB_TOPGEN], 1u);
            else XB_SPIN(xb_ld(&bar[XB_TOPGEN]) == tg, bar);
            __builtin_amdgcn_fence(__ATOMIC_ACQUIRE, "agent");
            xb_add(&bar[XB_XGEN(b.x)], 1u);
            asm volatile("s_waitcnt vmcnt(0)" ::: "memory");
        } else {
            XB_SPIN(xb_ld(&bar[XB_XGEN(b.x)]) == gen, bar);
            __builtin_amdgcn_fence(__ATOMIC_ACQUIRE, "agent");
            asm volatile("s_waitcnt vmcnt(0)" ::: "memory");
        }
    }
    __syncthreads();
}

constexpr size_t MiB = 1u << 20;
constexpr size_t WS_BAR = 2 * MiB + 512 * 1024, BAR_BYTES = 16384;
constexpr size_t WS_SSQH = 0, WS_SSQL = 2 * MiB, WS_SSQQ = 3 * MiB, WS_CS = 4 * MiB, WS_HB = 12 * MiB, WS_W = 76 * MiB;
constexpr size_t SZ_WIN = (size_t)3072 * 1024 * 2, SZ_WSQ = (size_t)1024 * 1024 * 2, SZ_W13 = (size_t)5632 * 1024 * 2, SZ_W2 = (size_t)1024 * 2816 * 2;
constexpr size_t OW_WIN = 0, OW_WOUT = SZ_WIN, OW_CW13 = SZ_WIN + SZ_WSQ, OW_CW2 = OW_CW13 + SZ_W13, SZ_CONV = OW_CW2 + SZ_W2;
constexpr size_t OW_DKVQ = 2 * SZ_CONV, OW_WK = OW_DKVQ + SZ_WSQ, SZ_WK = (size_t)1024 * 256 * 2, OW_WVT = OW_WK + SZ_WK;
constexpr size_t OW_WUQ = OW_WVT + SZ_WK, SZ_WUQ = (size_t)1536 * 384 * 2, OW_WDQ1 = OW_WUQ + 2 * SZ_WUQ, SZ_WDQ1 = (size_t)512 * 1024 * 2;
constexpr size_t OW_WO = OW_WDQ1 + SZ_WDQ1, OW_MW13 = OW_WO + 2 * SZ_WSQ, OW_MW2 = OW_MW13 + 2 * SZ_W13, SZ_WALL = OW_MW2 + 2 * SZ_W2;
static_assert(SZ_WALL <= 93 * MiB, "weights");
constexpr size_t WS_KN = 169 * MiB, WS_VT = 233 * MiB, WS_KPE = 297 * MiB, WS_ACT = 301 * MiB, WS_END = 477 * MiB;
constexpr size_t WS_Z = WS_KN, WS_GB = WS_VT, WS_Y = WS_ACT;
constexpr size_t WS_Q = WS_ACT, WS_ATT = WS_ACT + 96 * MiB, WS_CLAT = WS_ACT + 96 * MiB, WS_CQ = WS_ACT + 112 * MiB;

constexpr int LDS_BYTES = 140288;

struct Params { const float* in[22]; float* out; unsigned char* ws; };

__device__ __forceinline__ float wave_sum(float v) {
#pragma unroll
    for (int o = 1; o < 64; o <<= 1) v += __shfl_xor(v, o);
    return v;
}
template <int MAP> __device__ __forceinline__ int map_src(int n0) {
    if (MAP == 0) return n0;
    if (MAP == 1) { if (n0 < 2048) { const int pn = n0 >> 8, bj = (n0 >> 7) & 1, i = n0 & 127; return 1024 + 1024 * bj + 128 * pn + i; } return n0 - 2048; }
    if (MAP == 2) { const int pn = n0 >> 8, bj = (n0 >> 7) & 1, i = n0 & 127; return bj * 2816 + 128 * pn + i; }
    if (MAP == 3) { if (n0 < 256) return n0; const int i = n0 - 256, bj = i >> 7, ii = i & 127; return ii == 0 ? 256 + 32 * bj : -1; }
    if (MAP == 4) return n0 < 384 ? n0 : -1;
    if (MAP == 5) { const int hh = n0 >> 7, i = n0 & 127; return 256 * hh + i; }
    if (MAP == 6) { const int hh = n0 >> 7, i = n0 & 127; return 256 * hh + 128 + i; }
    if (MAP == 7) { if (n0 < 1024) { const int hh = n0 >> 7, i = n0 & 127; return 192 * hh + i; }
                    const int q = n0 - 1024, pnr = q >> 8, bj = (q >> 7) & 1, i = q & 127, hh = 4 * pnr + (i >> 5); return 192 * hh + 128 + 32 * bj; }
    return n0;
}
template <int MAP> __device__ __forceinline__ void transpose_item(const float* __restrict__ W, int K, int Ns, int Nd, const float* __restrict__ gain, bf16_t* __restrict__ WT, LAS float* scr, int item, int lane) {
    const int nblk = Nd / 32, kb = item / nblk, nb = item - kb * nblk, k0 = 64 * kb, n0 = 32 * nb;
    const int src = map_src<MAP>(n0);
    float v[32];
    if (src >= 0) { const float* wp = W + (size_t)(k0 + (lane >> 5)) * Ns + src + (lane & 31);
#pragma unroll
        for (int i = 0; i < 32; ++i) v[i] = __builtin_nontemporal_load(wp + (size_t)(2 * i) * Ns);
    } else {
#pragma unroll
        for (int i = 0; i < 32; ++i) v[i] = 0.f; }
    const int c = lane & 7;
    f32x4 g0 = {1.f, 1.f, 1.f, 1.f}, g1 = g0;
    if (gain) { g0 = *(const f32x4*)(gain + k0 + 8 * c); g1 = *(const f32x4*)(gain + k0 + 8 * c + 4); }
#pragma unroll
    for (int i = 0; i < 32; ++i) scr[(2 * i + (lane >> 5)) * 33 + (lane & 31)] = v[i];
    asm volatile("s_waitcnt lgkmcnt(0)" ::: "memory");
#pragma unroll
    for (int j = 0; j < 4; ++j) { const int n = (lane >> 3) + 8 * j; const LAS float* s = scr + (8 * c) * 33 + n;
        u32x4 o; o.x = pk_bf16(s[0 * 33] * g0[0], s[1 * 33] * g0[1]); o.y = pk_bf16(s[2 * 33] * g0[2], s[3 * 33] * g0[3]); o.z = pk_bf16(s[4 * 33] * g1[0], s[5 * 33] * g1[1]); o.w = pk_bf16(s[6 * 33] * g1[2], s[7 * 33] * g1[3]);
        *(u32x4*)(WT + (size_t)(n0 + n) * K + k0 + 8 * c) = o; }
    asm volatile("s_waitcnt lgkmcnt(0)" ::: "memory");
}

__device__ __forceinline__ void prologue(const Params& p, LAS unsigned char* lds) {
    int tid_ = threadIdx.x; asm volatile("" : "+v"(tid_));
    const int tid = tid_, lane = tid & 63, wave = __builtin_amdgcn_readfirstlane(tid >> 6);
    const int gw = blockIdx.x * 8 + wave, NGW = gridDim.x * 8;
    LAS float* scr = (LAS float*)(lds + wave * 16384);
    unsigned char* ws = p.ws; bf16_t* wb = (bf16_t*)(ws + WS_W);
    constexpr int I_WIN = 16 * 96, I_SQ = 16 * 32, I_W13 = 16 * 176, I_W2 = 44 * 32, I_DKV = 16 * 16, I_DQ = 16 * 16, I_WK = 4 * 32, I_WUQ = 6 * 48;
#define BFW(off) ((bf16_t*)((unsigned char*)wb + (off)))
    int base = 0;
#define JOB(MAP, W, K, Ns, Nd, G, DST, CNT) do { for (int it = (gw + NGW - base % NGW) % NGW; it < (CNT); it += NGW) transpose_item<MAP>((W), (K), (Ns), (Nd), (G), (DST), scr, it, lane); base += (CNT); } while (0)
    for (int l = 0; l < 2; ++l) {
        JOB(1, p.in[3] + (size_t)l * 1024 * 3072, 1024, 3072, 3072, p.in[2] + l * 1024, BFW(l * SZ_CONV + OW_WIN), I_WIN);
        JOB(0, p.in[5] + (size_t)l * 1024 * 1024, 1024, 1024, 1024, (const float*)nullptr, BFW(l * SZ_CONV + OW_WOUT), I_SQ);
        JOB(2, p.in[7] + (size_t)l * 1024 * 5632, 1024, 5632, 5632, p.in[6] + l * 1024, BFW(l * SZ_CONV + OW_CW13), I_W13);
        JOB(0, p.in[8] + (size_t)l * 2816 * 1024, 2816, 1024, 1024, (const float*)nullptr, BFW(l * SZ_CONV + OW_CW2), I_W2);
    }
    JOB(3, p.in[10], 1024, 320, 512, p.in[9], BFW(OW_DKVQ), I_DKV);
    JOB(4, p.in[14], 1024, 384, 512, p.in[13], BFW(OW_DKVQ + (size_t)512 * 1024 * 2), I_DQ);
    JOB(5, p.in[12], 256, 2048, 1024, p.in[11], BFW(OW_WK), I_WK);
    JOB(6, p.in[12], 256, 2048, 1024, p.in[11], BFW(OW_WVT), I_WK);
    JOB(4, p.in[14] + (size_t)1024 * 384, 1024, 384, 512, p.in[13] + 1024, BFW(OW_WDQ1), I_DQ);
    for (int j = 0; j < 2; ++j) {
        JOB(7, p.in[16] + (size_t)j * 384 * 1536, 384, 1536, 1536, p.in[15] + j * 384, BFW(OW_WUQ + j * SZ_WUQ), I_WUQ);
        JOB(0, p.in[17] + (size_t)j * 1024 * 1024, 1024, 1024, 1024, (const float*)nullptr, BFW(OW_WO + j * SZ_WSQ), I_SQ);
        JOB(2, p.in[19] + (size_t)j * 1024 * 5632, 1024, 5632, 5632, p.in[18] + j * 1024, BFW(OW_MW13 + j * SZ_W13), I_W13);
        JOB(0, p.in[20] + (size_t)j * 2816 * 1024, 2816, 1024, 1024, (const float*)nullptr, BFW(OW_MW2 + j * SZ_W2), I_W2);
    }
#undef JOB
#undef BFW
    { const float* x = p.in[0]; bf16_t* HB = (bf16_t*)(ws + WS_HB); float* ssq = (float*)(ws + WS_SSQH);
      for (int row0 = gw * 4; row0 < T_; row0 += NGW * 4) { f32x4 v[4][4];
#pragma unroll
          for (int r = 0; r < 4; ++r)
#pragma unroll
              for (int j = 0; j < 4; ++j) v[r][j] = __builtin_nontemporal_load((const f32x4*)(x + (size_t)(row0 + r) * 1024) + lane + 64 * j);
#pragma unroll
          for (int r = 0; r < 4; ++r) { float s = 0.f;
#pragma unroll
              for (int j = 0; j < 4; ++j) { s += pg8::dot4(v[r][j]); u32x2 w; w.x = pk_bf16(v[r][j][0], v[r][j][1]); w.y = pk_bf16(v[r][j][2], v[r][j][3]); *((u32x2*)(HB + (size_t)(row0 + r) * 1024) + lane + 64 * j) = w; }
              s = wave_sum(s); if (lane < 16) ssq[(size_t)(row0 + r) * 16 + lane] = lane == 0 ? s : 0.f; } } }
    { const int* pos = (const int*)p.in[1]; float* CS = (float*)(ws + WS_CS);
      for (int idx = blockIdx.x * 512 + tid; idx < T_ * 32; idx += gridDim.x * 512) { const int row = idx >> 5, j = idx & 31;
          double f = 1.0; for (int i = 0; i < j; ++i) f *= 0.74989420933245582730;
          const float ang = (float)pos[row] * (float)f;
          const double xr = (double)ang * 0.15915494309189533577; const float fr = (float)(xr - __builtin_rint(xr));
          CS[(size_t)idx * 2] = __builtin_amdgcn_cosf(fr); CS[(size_t)idx * 2 + 1] = __builtin_amdgcn_sinf(fr); } }
}

__device__ __forceinline__ void bf8_to_f32(const u32x4 v, float* f) {
#pragma unroll
    for (int i = 0; i < 4; ++i) { f[2 * i] = __uint_as_float(v[i] << 16); f[2 * i + 1] = __uint_as_float(v[i] & 0xffff0000u); }
}
__device__ __forceinline__ void conv_phase(const bf16_t* __restrict__ Z, const bf16_t* __restrict__ GB, const float* __restrict__ cw, bf16_t* __restrict__ Y) {
    int tid_ = threadIdx.x; asm volatile("" : "+v"(tid_));
    const int tid = tid_, c8 = (tid & 127) * 8, rg = tid >> 7;
    f32x4 w0a = *(const f32x4*)(cw + c8), w0b = *(const f32x4*)(cw + c8 + 4), w1a = *(const f32x4*)(cw + 1024 + c8), w1b = *(const f32x4*)(cw + 1024 + c8 + 4), w2a = *(const f32x4*)(cw + 2048 + c8), w2b = *(const f32x4*)(cw + 2048 + c8 + 4);
    for (int ch = blockIdx.x; ch < T_ / 64; ch += gridDim.x) { const int row0 = ch * 64 + rg * 16;
        f32x4 m2a = {0.f, 0.f, 0.f, 0.f}, m2b = m2a, m1a = m2a, m1b = m2a;
        if ((row0 & (SEQ - 1)) != 0) { float f[8]; bf8_to_f32(*(const u32x4*)(Z + (size_t)(row0 - 2) * 1024 + c8), f); m2a = (f32x4){f[0], f[1], f[2], f[3]}; m2b = (f32x4){f[4], f[5], f[6], f[7]};
            bf8_to_f32(*(const u32x4*)(Z + (size_t)(row0 - 1) * 1024 + c8), f); m1a = (f32x4){f[0], f[1], f[2], f[3]}; m1b = (f32x4){f[4], f[5], f[6], f[7]}; }
#pragma unroll 4
        for (int i = 0; i < 16; ++i) { const size_t off = (size_t)(row0 + i) * 1024 + c8; float f[8], g[8];
            bf8_to_f32(*(const u32x4*)(Z + off), f); bf8_to_f32(*(const u32x4*)(GB + off), g);
            const f32x4 za = {f[0], f[1], f[2], f[3]}, zb = {f[4], f[5], f[6], f[7]}, ga = {g[0], g[1], g[2], g[3]}, gb = {g[4], g[5], g[6], g[7]};
            const f32x4 ya = ga * (w0a * m2a + w1a * m1a + w2a * za), yb = gb * (w0b * m2b + w1b * m1b + w2b * zb);
            *(u32x4*)(Y + off) = pk8(ya, yb); m2a = m1a; m2b = m1b; m1a = za; m1b = zb; }
    }
}
__device__ __forceinline__ void final_norm(float* out, const bf16_t* hb, const float* ssq, const float* g) {
    int tid_ = threadIdx.x; asm volatile("" : "+v"(tid_));
    const int tid = tid_, lane = tid & 63, wave = tid >> 6; const int gw = blockIdx.x * 8 + wave, NGW = gridDim.x * 8;
    for (int row = gw; row < T_; row += NGW) { const float r = pg8::rstd_of<16>(ssq, row, 1.0f / 1024.0f);
#pragma unroll
        for (int j = 0; j < 2; ++j) { const int c = (lane + 64 * j) * 8; const u32x4 v = *(const u32x4*)(hb + (size_t)row * 1024 + c); float f[8]; bf8_to_f32(v, f);
            const f32x4 g0 = *(const f32x4*)(g + c), g1 = *(const f32x4*)(g + c + 4);
            *(f32x4*)(out + (size_t)row * 1024 + c) = (f32x4){f[0], f[1], f[2], f[3]} * r * g0; *(f32x4*)(out + (size_t)row * 1024 + c + 4) = (f32x4){f[4], f[5], f[6], f[7]} * r * g1; } }
}

__device__ __forceinline__ void conv_fix_rows(const bf16_t* __restrict__ Z, const bf16_t* __restrict__ GB, const float* __restrict__ cw, bf16_t* __restrict__ Y, int M, int N) {
    int tid_ = threadIdx.x; asm volatile("" : "+v"(tid_));
    const int tid = tid_;
    pg8::StaticOrder S; S.init(M, N, (int)gridDim.x, (int)blockIdx.x); pg8::Unit u;
    if (tid < 256) { const int r = tid >> 7, c8 = (tid & 127) * 8;
        const f32x4 w0a = *(const f32x4*)(cw + c8), w0b = *(const f32x4*)(cw + c8 + 4), w1a = *(const f32x4*)(cw + 1024 + c8), w1b = *(const f32x4*)(cw + 1024 + c8 + 4), w2a = *(const f32x4*)(cw + 2048 + c8), w2b = *(const f32x4*)(cw + 2048 + c8 + 4);
        for (int i = 0; S.next(i, u); ++i) { const int row = u.pm * 256 + r, t = row & (SEQ - 1); const size_t off = (size_t)row * 1024 + c8;
            f32x4 za, zb, ga, gb, z1a = {0.f, 0.f, 0.f, 0.f}, z1b = z1a, z2a = z1a, z2b = z1a;
            pg8::unpack8(*(const u32x4*)(Z + off), za, zb); pg8::unpack8(*(const u32x4*)(GB + off), ga, gb);
            if (t >= 1) pg8::unpack8(*(const u32x4*)(Z + off - 1024), z1a, z1b);
            if (t >= 2) pg8::unpack8(*(const u32x4*)(Z + off - 2048), z2a, z2b);
            *(u32x4*)(Y + off) = pk8(ga * (w0a * z2a + w1a * z1a + w2a * za), gb * (w0b * z2b + w1b * z1b + w2b * zb)); } }
    asm volatile("s_waitcnt vmcnt(0)" ::: "memory"); __syncthreads();
}

#define GEMM_PHASE(EPI, A_, B_, M_, N_, K_, E_) do { int k_ = (K_); asm volatile("" : "+s"(k_)); pg8::Gemm g_{(const bf16_t*)(A_), (const bf16_t*)(B_), (M_), (N_), k_}; pg8::StaticOrder S_; S_.init((M_), (N_), (int)gridDim.x, (int)blockIdx.x); \
        pg8::gemm_phase<EPI, pg8::StaticOrder, true, true>(lds, g_, S_, (E_)); } while (0)

typedef __attribute__((address_space(1))) unsigned char gbyte_t;
__device__ __forceinline__ unsigned char* fresh(unsigned char* q) { gbyte_t* g = (gbyte_t*)q; asm volatile("" : "+s"(g)); return (unsigned char*)g; }
#ifndef PH
#define PH 0xFFFF
#endif
#ifndef PROBE
#define PROBE 0
#endif
#define WSP(T, off) ((T*)(ws + (off)))
__global__ void __launch_bounds__(512, 2) yoco_fwd(Params p) {
    extern __shared__ __attribute__((aligned(16))) unsigned char lds_raw[];
    LAS unsigned char* lds = (LAS unsigned char*)lds_raw;
    cg::grid_group grid = cg::this_grid();
    volatile LAS unsigned* bst = (volatile LAS unsigned*)(lds + 131072);
    if (threadIdx.x < 2) bst[threadIdx.x] = 0u;
    __syncthreads();
    XcdBarrier xbar = xcd_barrier_post((unsigned*)(p.ws + WS_BAR), bst);
    if (PH & 1) prologue(p, lds);
    grid.sync();
    if (PROBE == 2) { prologue(p, lds); xcd_barrier(xbar); }
    if (PROBE == 3) { for (int i = 0; i < 20; ++i) xcd_barrier(xbar); }
    for (int l = 0; l < 2; ++l) {
        for (int rep = 0; rep < (PROBE == 5 ? 2 : 1); ++rep) {
        if (PH & 2) { unsigned char* ws = fresh(p.ws); int cpm_ = -1; pg8::EpiConvFused E{WSP(float, WS_SSQH), WSP(bf16_t, WS_Z), WSP(bf16_t, WS_GB), WSP(bf16_t, WS_Y), p.in[4] + l * 3 * 1024, (LAS float*)(lds + 132096), cpm_};
            int k_ = 1024; asm volatile("" : "+s"(k_)); pg8::Gemm g_{(const bf16_t*)(ws + WS_HB), (const bf16_t*)(ws + WS_W + l * SZ_CONV + OW_WIN), T_, 3072, k_}; pg8::TripleOrder S_; S_.init((int)gridDim.x, (int)blockIdx.x);
            pg8::gemm_phase<pg8::EpiConvFused, pg8::TripleOrder, true, true>(lds, g_, S_, E); }
        xcd_barrier(xbar);
        }
        if (PH & 8) { unsigned char* ws = fresh(p.ws); conv_fix_rows(WSP(bf16_t, WS_Z), WSP(bf16_t, WS_GB), p.in[4] + l * 3 * 1024, WSP(bf16_t, WS_Y), T_, 1024); if (l == 0) { pg8::EpiResid<true> E{p.in[0], WSP(bf16_t, WS_HB), WSP(float, WS_SSQH)}; GEMM_PHASE(pg8::EpiResid<true>, ws + WS_Y, ws + WS_W + l * SZ_CONV + OW_WOUT, T_, 1024, 1024, E); }
            else { pg8::EpiResid<false> E{nullptr, WSP(bf16_t, WS_HB), WSP(float, WS_SSQH)}; GEMM_PHASE(pg8::EpiResid<false>, ws + WS_Y, ws + WS_W + l * SZ_CONV + OW_WOUT, T_, 1024, 1024, E); } }
        xcd_barrier(xbar);
        for (int rep = 0; rep < (PROBE == 4 ? 2 : 1); ++rep) {
        if (PH & 16) { unsigned char* ws = fresh(p.ws); int cpm_ = -1; pg8::EpiSwiglu E{WSP(float, WS_SSQH), WSP(bf16_t, WS_ACT), (LAS float*)(lds + 132096), cpm_};
            GEMM_PHASE(pg8::EpiSwiglu, ws + WS_HB, ws + WS_W + l * SZ_CONV + OW_CW13, T_, 5632, 1024, E); }
        xcd_barrier(xbar);
        }
        if (PH & 8) { unsigned char* ws = fresh(p.ws); pg8::EpiResid<false> E{nullptr, WSP(bf16_t, WS_HB), WSP(float, WS_SSQH)};
            GEMM_PHASE(pg8::EpiResid<false>, ws + WS_ACT, ws + WS_W + l * SZ_CONV + OW_CW2, T_, 1024, 2816, E); }
        xcd_barrier(xbar);
    }
    for (int j = 0; j < 2; ++j) {
        if (PH & 32) { unsigned char* ws = fresh(p.ws); pg8::EpiDKVQ E{WSP(float, WS_SSQH), j == 0 ? 0 : 2, WSP(bf16_t, WS_CLAT), WSP(float, WS_SSQL), WSP(bf16_t, WS_KPE), WSP(float, WS_CS), WSP(bf16_t, WS_CQ), WSP(float, WS_SSQQ)};
            GEMM_PHASE(pg8::EpiDKVQ, ws + WS_HB, ws + WS_W + (j == 0 ? OW_DKVQ : OW_WDQ1), T_, (j == 0 ? 1024 : 512), 1024, E); }
        xcd_barrier(xbar);
        if (j == 0) {
            if (PH & 64) { unsigned char* ws = fresh(p.ws); pg8::EpiRowScale E{WSP(float, WS_SSQL), WSP(bf16_t, WS_KN)}; GEMM_PHASE(pg8::EpiRowScale, ws + WS_CLAT, ws + WS_W + OW_WK, T_, 1024, 256, E); }
            if (PH & 128) { unsigned char* ws = fresh(p.ws); pg8::EpiVT E{WSP(float, WS_SSQL), WSP(bf16_t, WS_VT)}; GEMM_PHASE(pg8::EpiVT, ws + WS_W + OW_WVT, ws + WS_CLAT, 1024, T_, 256, E); }
        }
        if (PH & 256) { unsigned char* ws = fresh(p.ws); pg8::EpiQ E{WSP(float, WS_SSQQ), WSP(float, WS_CS), WSP(bf16_t, WS_Q), QSCALE}; GEMM_PHASE(pg8::EpiQ, ws + WS_CQ, ws + WS_W + OW_WUQ + j * SZ_WUQ, T_, 1536, 384, E); }
        xcd_barrier(xbar);
        if (PROBE == 1) { unsigned char* ws = fresh(p.ws); att::attn_phase(WSP(bf16_t, WS_Q), WSP(bf16_t, WS_KN), WSP(bf16_t, WS_KPE), WSP(bf16_t, WS_VT), WSP(bf16_t, WS_ATT), lds); xcd_barrier(xbar); }
        if (PH & 512) { unsigned char* ws = fresh(p.ws); att::attn_phase(WSP(bf16_t, WS_Q), WSP(bf16_t, WS_KN), WSP(bf16_t, WS_KPE), WSP(bf16_t, WS_VT), WSP(bf16_t, WS_ATT), lds); }
        xcd_barrier(xbar);
        if (PH & 8) { unsigned char* ws = fresh(p.ws); pg8::EpiResid<false> E{nullptr, WSP(bf16_t, WS_HB), WSP(float, WS_SSQH)};
            GEMM_PHASE(pg8::EpiResid<false>, ws + WS_ATT, ws + WS_W + OW_WO + j * SZ_WSQ, T_, 1024, 1024, E); }
        xcd_barrier(xbar);
        if (PH & 16) { unsigned char* ws = fresh(p.ws); int cpm_ = -1; pg8::EpiSwiglu E{WSP(float, WS_SSQH), WSP(bf16_t, WS_ACT), (LAS float*)(lds + 132096), cpm_};
            GEMM_PHASE(pg8::EpiSwiglu, ws + WS_HB, ws + WS_W + OW_MW13 + j * SZ_W13, T_, 5632, 1024, E); }
        xcd_barrier(xbar);
        if (PH & 8) { unsigned char* ws = fresh(p.ws); pg8::EpiResid<false> E{nullptr, WSP(bf16_t, WS_HB), WSP(float, WS_SSQH)};
            GEMM_PHASE(pg8::EpiResid<false>, ws + WS_ACT, ws + WS_W + OW_MW2 + j * SZ_W2, T_, 1024, 2816, E); }
        xcd_barrier(xbar);
    }
    if (PH & 1024) { unsigned char* ws = fresh(p.ws); final_norm(p.out, WSP(bf16_t, WS_HB), WSP(float, WS_SSQH), p.in[21]); }
}

extern "C" void kernel_launch(void* const* d_in, const int* in_sizes, int n_in, void* d_out, int out_size, void* d_ws, size_t ws_size, hipStream_t stream) {
    static int grid = 0;
    if (grid == 0) {
        if (n_in != 22 || out_size != T_ * DM || ws_size < WS_END) { fprintf(stderr, "kernel_launch: unexpected shapes (n_in %d, out %d, ws %zu)\n", n_in, out_size, ws_size); grid = -1; return; }
        int dev = 0, cus = 0, per_cu = 0;
        (void)hipGetDevice(&dev); (void)hipDeviceGetAttribute(&cus, hipDeviceAttributeMultiprocessorCount, dev);
        if (hipFuncSetAttribute((const void*)yoco_fwd, hipFuncAttributeMaxDynamicSharedMemorySize, LDS_BYTES) != hipSuccess) { fprintf(stderr, "kernel_launch: hipFuncSetAttribute failed\n"); grid = -1; return; }
        if (hipOccupancyMaxActiveBlocksPerMultiprocessor(&per_cu, (const void*)yoco_fwd, 512, LDS_BYTES) != hipSuccess || per_cu < 1) { fprintf(stderr, "kernel_launch: occupancy query gave %d\n", per_cu); per_cu = 1; }
        (void)hipGetLastError();
        grid = cus * 1;
        if (grid <= 0) grid = 256;
    }
    if (grid < 0) return;
    if (hipMemsetAsync((char*)d_ws + WS_BAR, 0, BAR_BYTES, stream) != hipSuccess) { fprintf(stderr, "kernel_launch: memset of barrier words failed\n"); return; }
    Params p{};
    for (int i = 0; i < 22; ++i) p.in[i] = (const float*)d_in[i];
    p.out = (float*)d_out; p.ws = (unsigned char*)d_ws;
    void* args[] = {&p};
    hipError_t e = hipLaunchCooperativeKernel((const void*)yoco_fwd, dim3(grid), dim3(512), args, LDS_BYTES, stream);
    if (e != hipSuccess) fprintf(stderr, "kernel_launch: cooperative launch failed: %s (grid %d)\n", hipGetErrorString(e), grid);
}
```

```cpp
#include <hip/hip_runtime.h>
#include <hip/hip_cooperative_groups.h>
#include <cstdio>
#include <cstdint>
namespace cg = cooperative_groups;

constexpr int T_ = 32768, DM = 1024, SEQ = 2048, NBATCH = 16, NHEAD = 8, DFF = 2816;
constexpr float RMS_EPS = 1e-6f;
constexpr float QSCALE = 0.07216878364870322f * 1.4426950408889634f;

namespace pg8 {
#define PG8_LAS __attribute__((address_space(3)))
typedef unsigned short bf16_t;
typedef short bf16x8 __attribute__((ext_vector_type(8)));
typedef float f32x4 __attribute__((ext_vector_type(4)));
typedef unsigned u32x4 __attribute__((ext_vector_type(4)));
constexpr int BM = 256, BK = 64, HALF = 128, HTB = HALF * BK * 2  , STAGE_BYTES = 8 * HTB, NXCD = 8, WGM = 8;

__host__ __device__ __forceinline__ int lds_byte(int r, int c) { const int st = (r >> 4) * 2 + (c >> 5), rr = r & 15, cc = c & 31, ob = rr * 64 + cc * 2; return st * 1024 + (ob ^ (((ob >> 9) & 1) << 5)); }
__host__ __device__ __forceinline__ void stage_rc(int b, int& R, int& C) { const int st = b / 1024, sb = b % 1024, swz = sb ^ (((sb >> 9) & 1) << 5); R = (st >> 1) * 16 + swz / 64; C = (st & 1) * 32 + (swz % 64) / 2; }
__host__ __device__ __forceinline__ int perm32(int rho) { const int n = rho >> 4, i = rho & 15; return 8 * (i >> 2) + 4 * n + (i & 3); }

struct Unit { int pm, pn; };
struct Gemm { const bf16_t* A; const bf16_t* Bt; int M, N, K; };

struct StaticOrder {
    int nM, nN, nwg, G, c;
    __host__ __device__ void init(int M, int N, int G_, int c_) { nM = M / BM; nN = N / BM; nwg = nM * nN; G = G_; c = c_; }
    __host__ __device__ bool next(int i, Unit& u) const {
        const long L = (long)i * G + c; if (L >= nwg) return false;
        int wgid = (int)L; { const int q = nwg / NXCD, r = nwg % NXCD, xcd = wgid % NXCD, off = wgid / NXCD; wgid = (xcd < r ? xcd * (q + 1) : r * (q + 1) + (xcd - r) * q) + off; }
        const int nig = WGM * nN, gid = wgid / nig, fm = gid * WGM, gsz = (nM - fm) < WGM ? (nM - fm) : WGM;
        u.pm = fm + ((wgid % nig) % gsz); u.pn = (wgid % nig) / gsz; return true;
    }
    __device__ __forceinline__ void a_ready(const Unit&) const {}
    __device__ __forceinline__ void done(const Unit&) const {}
};
typedef float f32x2_t __attribute__((ext_vector_type(2))); typedef __bf16 bf16x2_t __attribute__((ext_vector_type(2)));
typedef unsigned u32x2 __attribute__((ext_vector_type(2)));
__device__ __forceinline__ unsigned pk_bf16(float lo, float hi) { f32x2_t v = {lo, hi}; bf16x2_t b = __builtin_convertvector(v, bf16x2_t); return __builtin_bit_cast(unsigned, b); }
__device__ __forceinline__ u32x4 pk8(const f32x4 a, const f32x4 b) { u32x4 w; w.x = pk_bf16(a[0], a[1]); w.y = pk_bf16(a[2], a[3]); w.z = pk_bf16(b[0], b[1]); w.w = pk_bf16(b[2], b[3]); return w; }
__device__ __forceinline__ float dot4(const f32x4 a) { return (a[0] * a[0] + a[1] * a[1]) + (a[2] * a[2] + a[3] * a[3]); }
template <int NS> __device__ __forceinline__ float rstd_of(const float* part, int row, float invn) {
    float s = 0.f;
#pragma unroll
    for (int i = 0; i < NS / 4; ++i) { const f32x4 v = *(const f32x4*)(part + (size_t)row * NS + 4 * i); s += (v[0] + v[1]) + (v[2] + v[3]); }
    return __builtin_amdgcn_rsqf(s * invn + 1e-6f);
}
typedef const f32x4 (&AccRef)[2][2][4][2];
template <int NS> __device__ __forceinline__ void wave_rstd(const float* part, int pm, int wr, int lane, float invn, float (&r)[2][4]) {
    constexpr int QPR = NS / 4, RPL = 64 / QPR, NL = 128 / RPL;
    asm volatile("" : "+v"(lane));
    float t[NL];
#pragma unroll
    for (int i = 0; i < NL; ++i) { const int rl = lane / QPR + RPL * i, grow = pm * BM + HALF * (rl >> 6) + 64 * wr + (rl & 63);
        const f32x4 v = *(const f32x4*)(part + (size_t)grow * NS + 4 * (lane % QPR)); float sm = (v[0] + v[1]) + (v[2] + v[3]);
#pragma unroll
        for (int o = 1; o < QPR; o <<= 1) sm += __shfl_xor(sm, o);
        t[i] = __builtin_amdgcn_rsqf(sm * invn + 1e-6f); }
    const int fr = lane & 15;
#pragma unroll
    for (int ai = 0; ai < 2; ++ai)
#pragma unroll
        for (int m = 0; m < 4; ++m) { const int rl0 = 64 * ai + 16 * m; r[ai][m] = __shfl(t[rl0 / RPL], ((rl0 % RPL) + fr) * QPR); }
}


struct EpiConvIn {
    static constexpr bool PERM = true, AFTER_DRAIN = false;
    const float* ssq; bf16_t* Z; bf16_t* GB;
    __device__ __forceinline__ void operator()(AccRef acc, const Unit& u, int wr, int wc, int fr, int fq) const {
        const int row0 = u.pm * BM + wr * 64 + fr; float rs[2][4]; wave_rstd<16>(ssq, u.pm, wr, fq * 16 + fr, 1.0f / 1024.0f, rs);
#pragma unroll
        for (int ai = 0; ai < 2; ++ai)
#pragma unroll
            for (int m = 0; m < 4; ++m) { const int row = row0 + ai * HALF + m * 16; const float r = rs[ai][m];
                if (u.pn < 8) { const float r2 = r * r; const f32x4 z0 = acc[ai][0][m][0] * acc[ai][1][m][0] * r2, z1 = acc[ai][0][m][1] * acc[ai][1][m][1] * r2;
                    *(u32x4*)(Z + (size_t)row * 1024 + u.pn * 128 + wc * 32 + 8 * fq) = pk8(z0, z1); }
                else {
#pragma unroll
                    for (int bj = 0; bj < 2; ++bj) *(u32x4*)(GB + (size_t)row * 1024 + (u.pn - 8) * 256 + bj * HALF + wc * 32 + 8 * fq) = pk8(acc[ai][bj][m][0] * r, acc[ai][bj][m][1] * r); } }
    }
};
struct TripleOrder {
    int G, c;
    __host__ __device__ void init(int G_, int c_) { G = G_; c = c_; }
    __host__ __device__ bool next(int i, Unit& u) const {
        const int tr = i / 3, j = i - 3 * tr, tidx = tr * G + c; if (tidx >= 512) return false;
        const int w = (tidx & 7) * 64 + (tidx >> 3);
        u.pm = w >> 2; const int q = w & 3; u.pn = (j == 2) ? 8 + q : 2 * q + j; return true;
    }
    __device__ __forceinline__ void a_ready(const Unit&) const {}
    __device__ __forceinline__ void done(const Unit&) const {}
};
__device__ __forceinline__ void unpack8(const u32x4 v, f32x4& a, f32x4& b) {
    a = (f32x4){__uint_as_float(v.x << 16), __uint_as_float(v.x & 0xffff0000u), __uint_as_float(v.y << 16), __uint_as_float(v.y & 0xffff0000u)};
    b = (f32x4){__uint_as_float(v.z << 16), __uint_as_float(v.z & 0xffff0000u), __uint_as_float(v.w << 16), __uint_as_float(v.w & 0xffff0000u)};
}
struct EpiConvFused {
    static constexpr bool PERM = true, AFTER_DRAIN = false;
    const float* ssq; bf16_t* Z; bf16_t* GB; bf16_t* Y; const float* cw; PG8_LAS float* rcache; int& cached_pm;
    __device__ __forceinline__ void operator()(AccRef acc, const Unit& u, int wr, int wc, int fr, int fq) const {
        const int row0 = u.pm * BM + wr * 64 + fr; PG8_LAS float* rc = rcache + (wr * 4 + wc) * 128 + fr;
        if (u.pm != cached_pm) { float t[2][4]; wave_rstd<16>(ssq, u.pm, wr, fq * 16 + fr, 1.0f / 1024.0f, t);
            if (fq == 0) {
#pragma unroll
                for (int ai = 0; ai < 2; ++ai)
#pragma unroll
                    for (int m = 0; m < 4; ++m) rc[ai * 64 + m * 16] = t[ai][m]; }
            cached_pm = u.pm; }
        if (u.pn < 8) {
            const int col = u.pn * 128 + wc * 32 + 8 * fq;
#pragma unroll
            for (int ai = 0; ai < 2; ++ai)
#pragma unroll
                for (int m = 0; m < 4; ++m) { const int row = row0 + ai * HALF + m * 16; const float r1 = rc[ai * 64 + m * 16], r2 = r1 * r1;
                    *(u32x4*)(Z + (size_t)row * 1024 + col) = pk8(acc[ai][0][m][0] * acc[ai][1][m][0] * r2, acc[ai][0][m][1] * acc[ai][1][m][1] * r2); }
        } else {
            const int q = u.pn - 8;
#pragma unroll
            for (int bj = 0; bj < 2; ++bj) { const int col = q * 256 + bj * HALF + wc * 32 + 8 * fq;
                const f32x4 w0a = *(const f32x4*)(cw + col), w0b = *(const f32x4*)(cw + col + 4), w1a = *(const f32x4*)(cw + 1024 + col), w1b = *(const f32x4*)(cw + 1024 + col + 4),
                            w2a = *(const f32x4*)(cw + 2048 + col), w2b = *(const f32x4*)(cw + 2048 + col + 4);
#pragma unroll
                for (int ai = 0; ai < 2; ++ai)
#pragma unroll
                    for (int mh = 0; mh < 2; ++mh) { u32x4 zq[2][3];
#pragma unroll
                        for (int mm = 0; mm < 2; ++mm) { const int row = row0 + ai * HALF + (2 * mh + mm) * 16; const unsigned bo = (unsigned)(row * 1024 + col) * 2u; const bool ok = (row & 255) >= 2;
                            zq[mm][0] = *(const u32x4*)((const char*)Z + bo); zq[mm][1] = *(const u32x4*)((const char*)Z + (ok ? bo - 2048u : bo)); zq[mm][2] = *(const u32x4*)((const char*)Z + (ok ? bo - 4096u : bo)); }
                        asm volatile("" ::: "memory");
#pragma unroll
                        for (int mm = 0; mm < 2; ++mm) { const int m = 2 * mh + mm, row = row0 + ai * HALF + m * 16; const float r = rc[ai * 64 + m * 16]; const unsigned bo = (unsigned)(row * 1024 + col) * 2u;
                            const f32x4 ga = acc[ai][bj][m][0] * r, gb = acc[ai][bj][m][1] * r;
                            if ((row & 255) < 2) *(u32x4*)((char*)GB + bo) = pk8(ga, gb);
                            else { f32x4 z0a, z0b, z1a, z1b, z2a, z2b; unpack8(zq[mm][0], z0a, z0b); unpack8(zq[mm][1], z1a, z1b); unpack8(zq[mm][2], z2a, z2b);
                                *(u32x4*)((char*)Y + bo) = pk8(ga * (w0a * z2a + w1a * z1a + w2a * z0a), gb * (w0b * z2b + w1b * z1b + w2b * z0b)); } } } }
        }
    }
};
template <bool F32BASE> struct EpiResid {
    static constexpr bool PERM = true, AFTER_DRAIN = false;
    const float* xbase; bf16_t* hb; float* ssq;
    __device__ __forceinline__ void operator()(AccRef acc, const Unit& u, int wr, int wc, int fr, int fq) const {
        const int row0 = u.pm * BM + wr * 64 + fr, col0 = u.pn * BM + wc * 32 + 8 * fq;
        if (F32BASE) {
#pragma unroll
            for (int ai = 0; ai < 2; ++ai)
#pragma unroll
                for (int mh = 0; mh < 2; ++mh) { f32x4 b[2][2][2];
#pragma unroll
                    for (int mm = 0; mm < 2; ++mm)
#pragma unroll
                        for (int bj = 0; bj < 2; ++bj) { const size_t off = (size_t)(row0 + ai * HALF + (2 * mh + mm) * 16) * 1024 + col0 + bj * HALF; b[mm][bj][0] = *(const f32x4*)(xbase + off); b[mm][bj][1] = *(const f32x4*)(xbase + off + 4); }
                    asm volatile("" ::: "memory");
#pragma unroll
                    for (int mm = 0; mm < 2; ++mm) { const int m = 2 * mh + mm, row = row0 + ai * HALF + m * 16; float s = 0.f;
#pragma unroll
                        for (int bj = 0; bj < 2; ++bj) { const size_t off = (size_t)row * 1024 + col0 + bj * HALF; const f32x4 o0 = b[mm][bj][0] + acc[ai][bj][m][0], o1 = b[mm][bj][1] + acc[ai][bj][m][1];
                            *(u32x4*)(hb + off) = pk8(o0, o1); s += dot4(o0) + dot4(o1); }
                        s += __shfl_xor(s, 16); s += __shfl_xor(s, 32);
                        if (fq == 0) ssq[(size_t)row * 16 + u.pn * 4 + wc] = s; } }
        } else {
#pragma unroll
            for (int ai = 0; ai < 2; ++ai) { u32x4 old[4][2];
#pragma unroll
                for (int m = 0; m < 4; ++m)
#pragma unroll
                    for (int bj = 0; bj < 2; ++bj) old[m][bj] = *(const u32x4*)(hb + (size_t)(row0 + ai * HALF + m * 16) * 1024 + col0 + bj * HALF);
                asm volatile("" ::: "memory");
#pragma unroll
                for (int m = 0; m < 4; ++m) { const int row = row0 + ai * HALF + m * 16; float s = 0.f;
#pragma unroll
                    for (int bj = 0; bj < 2; ++bj) { const size_t off = (size_t)row * 1024 + col0 + bj * HALF; f32x4 b0, b1; unpack8(old[m][bj], b0, b1);
                        const f32x4 o0 = b0 + acc[ai][bj][m][0], o1 = b1 + acc[ai][bj][m][1];
                        *(u32x4*)(hb + off) = pk8(o0, o1); s += dot4(o0) + dot4(o1); }
                    s += __shfl_xor(s, 16); s += __shfl_xor(s, 32);
                    if (fq == 0) ssq[(size_t)row * 16 + u.pn * 4 + wc] = s; } }
        }
    }
};
struct EpiSwiglu {
    static constexpr bool PERM = true, AFTER_DRAIN = false;
    const float* ssq; bf16_t* ACT; PG8_LAS float* rcache; int& cached_pm;
    __device__ __forceinline__ void operator()(AccRef acc, const Unit& u, int wr, int wc, int fr, int fq) const {
        const int row0 = u.pm * BM + wr * 64 + fr; PG8_LAS float* rc = rcache + (wr * 4 + wc) * 128 + fr;
        if (u.pm != cached_pm) { float t[2][4]; wave_rstd<16>(ssq, u.pm, wr, fq * 16 + fr, 1.0f / 1024.0f, t);
            if (fq == 0) {
#pragma unroll
                for (int ai = 0; ai < 2; ++ai)
#pragma unroll
                    for (int m = 0; m < 4; ++m) { const float r_ = t[ai][m]; rc[ai * 64 + m * 16] = -1.4426950408889634f * r_; rc[1024 + ai * 64 + m * 16] = __builtin_amdgcn_rcpf(r_ * r_); } }
            cached_pm = u.pm; }
        float rs[2][4], rq[2][4];
#pragma unroll
        for (int ai = 0; ai < 2; ++ai)
#pragma unroll
            for (int m = 0; m < 4; ++m) { rs[ai][m] = rc[ai * 64 + m * 16]; rq[ai][m] = rc[1024 + ai * 64 + m * 16]; }
#pragma unroll
        for (int ai = 0; ai < 2; ++ai)
#pragma unroll
            for (int m = 0; m < 4; ++m) { const int row = row0 + ai * HALF + m * 16; const float c = rs[ai][m], ir2 = rq[ai][m]; f32x4 a[2];
#pragma unroll
                for (int n = 0; n < 2; ++n) { const f32x4 x = acc[ai][0][m][n] * c, gu = acc[ai][0][m][n] * acc[ai][1][m][n];
#pragma unroll
                    for (int e = 0; e < 4; ++e) a[n][e] = gu[e] * __builtin_amdgcn_rcpf(__builtin_fmaf(__builtin_amdgcn_exp2f(x[e]), ir2, ir2)); }
                __builtin_nontemporal_store(pk8(a[0], a[1]), (u32x4*)((char*)ACT + (unsigned)((row * 2816 + u.pn * 128 + wc * 32 + 8 * fq) * 2))); }
    }
};
struct EpiDKVQ {
    static constexpr bool PERM = true, AFTER_DRAIN = false;
    const float* ssq; int pn_off; bf16_t* CLAT; float* ssql; bf16_t* KPE; const float* CS; bf16_t* CQ; float* ssqq;
    __device__ __forceinline__ void operator()(AccRef acc, const Unit& u, int wr, int wc, int fr, int fq) const {
        const int row0 = u.pm * BM + wr * 64 + fr, pn = u.pn + pn_off; float rs[2][4]; wave_rstd<16>(ssq, u.pm, wr, fq * 16 + fr, 1.0f / 1024.0f, rs);
#pragma unroll
        for (int ai = 0; ai < 2; ++ai)
#pragma unroll
            for (int m = 0; m < 4; ++m) { const int row = row0 + ai * HALF + m * 16; const float r = rs[ai][m];
                if (pn == 0) { float s = 0.f;
#pragma unroll
                    for (int bj = 0; bj < 2; ++bj) { const f32x4 a = acc[ai][bj][m][0] * r, b = acc[ai][bj][m][1] * r; s += dot4(a) + dot4(b);
                        *(u32x4*)(CLAT + (size_t)row * 256 + bj * HALF + wc * 32 + 8 * fq) = pk8(a, b); }
                    s += __shfl_xor(s, 16); s += __shfl_xor(s, 32);
                    if (fq == 0) ssql[(size_t)row * 4 + wc] = s;
                } else if (pn == 1) {
                    if (wc == 0) { f32x4 o1[2], o2[2];
#pragma unroll
                        for (int n = 0; n < 2; ++n) { const f32x4 x1 = acc[ai][0][m][n] * r, x2 = acc[ai][1][m][n] * r; const float* cs = CS + ((size_t)row * 32 + 8 * fq + 4 * n) * 2;
                            const f32x4 c01 = *(const f32x4*)cs, c23 = *(const f32x4*)(cs + 4);
                            const f32x4 co = {c01[0], c01[2], c23[0], c23[2]}, si = {c01[1], c01[3], c23[1], c23[3]};
                            o1[n] = x1 * co - x2 * si; o2[n] = x1 * si + x2 * co; }
                        *(u32x4*)(KPE + (size_t)row * 64 + 8 * fq) = pk8(o1[0], o1[1]); *(u32x4*)(KPE + (size_t)row * 64 + 32 + 8 * fq) = pk8(o2[0], o2[1]); }
                } else { const int t = pn - 2; float s = 0.f;
#pragma unroll
                    for (int bj = 0; bj < 2; ++bj) { const f32x4 a = acc[ai][bj][m][0] * r, b = acc[ai][bj][m][1] * r; s += dot4(a) + dot4(b);
                        if (t == 0 || bj == 0) *(u32x4*)(CQ + (size_t)row * 384 + t * 256 + bj * HALF + wc * 32 + 8 * fq) = pk8(a, b); }
                    s += __shfl_xor(s, 16); s += __shfl_xor(s, 32);
                    if (fq == 0) ssqq[(size_t)row * 8 + t * 4 + wc] = s; } }
    }
};
struct EpiRowScale {
    static constexpr bool PERM = true, AFTER_DRAIN = false;
    const float* ssql; bf16_t* O;
    __device__ __forceinline__ void operator()(AccRef acc, const Unit& u, int wr, int wc, int fr, int fq) const {
        const int row0 = u.pm * BM + wr * 64 + fr; float rr[2][4];
#pragma unroll
        for (int ai = 0; ai < 2; ++ai)
#pragma unroll
            for (int m = 0; m < 4; ++m) rr[ai][m] = rstd_of<4>(ssql, row0 + ai * HALF + m * 16, 1.0f / 256.0f);
        asm volatile("" ::: "memory");
#pragma unroll
        for (int ai = 0; ai < 2; ++ai)
#pragma unroll
            for (int m = 0; m < 4; ++m) { const int row = row0 + ai * HALF + m * 16; const float r = rr[ai][m];
#pragma unroll
                for (int bj = 0; bj < 2; ++bj) *(u32x4*)(O + (size_t)row * 1024 + u.pn * BM + bj * HALF + wc * 32 + 8 * fq) = pk8(acc[ai][bj][m][0] * r, acc[ai][bj][m][1] * r); }
    }
};
struct EpiVT {
    static constexpr bool PERM = true, AFTER_DRAIN = false;
    const float* ssql; bf16_t* VT;
    __device__ __forceinline__ void operator()(AccRef acc, const Unit& u, int wr, int wc, int fr, int fq) const {
        const int row0 = u.pm * BM + wr * 64 + fr;
#pragma unroll
        for (int bj = 0; bj < 2; ++bj) { const int c0 = u.pn * BM + bj * HALF + wc * 32 + 8 * fq; f32x4 r0, r1;
#pragma unroll
            for (int e = 0; e < 4; ++e) { r0[e] = rstd_of<4>(ssql, c0 + e, 1.0f / 256.0f); r1[e] = rstd_of<4>(ssql, c0 + 4 + e, 1.0f / 256.0f); }
            const int b = c0 >> 11, s = c0 & 2047;
#pragma unroll
            for (int ai = 0; ai < 2; ++ai)
#pragma unroll
                for (int m = 0; m < 4; ++m) { const int row = row0 + ai * HALF + m * 16;
                    *(u32x4*)(VT + ((size_t)b * 1024 + row) * 2048 + s) = pk8(acc[ai][bj][m][0] * r0, acc[ai][bj][m][1] * r1); } }
    }
};
struct EpiQ {
    static constexpr bool PERM = true, AFTER_DRAIN = false;
    const float* ssqq; const float* CS; bf16_t* Q; float qscale;
    __device__ __forceinline__ void operator()(AccRef acc, const Unit& u, int wr, int wc, int fr, int fq) const {
        const int row0 = u.pm * BM + wr * 64 + fr; float rs[2][4]; wave_rstd<8>(ssqq, u.pm, wr, fq * 16 + fr, 1.0f / 384.0f, rs);
#pragma unroll
        for (int ai = 0; ai < 2; ++ai)
#pragma unroll
            for (int m = 0; m < 4; ++m) { const int row = row0 + ai * HALF + m * 16; const float r = rs[ai][m] * qscale;
                if (u.pn < 4) {
#pragma unroll
                    for (int bj = 0; bj < 2; ++bj) *(u32x4*)(Q + (size_t)row * 1536 + (2 * u.pn + bj) * 192 + wc * 32 + 8 * fq) = pk8(acc[ai][bj][m][0] * r, acc[ai][bj][m][1] * r);
                } else { f32x4 o1[2], o2[2];
#pragma unroll
                    for (int n = 0; n < 2; ++n) { const f32x4 x1 = acc[ai][0][m][n] * r, x2 = acc[ai][1][m][n] * r; const float* cs = CS + ((size_t)row * 32 + 8 * fq + 4 * n) * 2;
                        const f32x4 c01 = *(const f32x4*)cs, c23 = *(const f32x4*)(cs + 4);
                        const f32x4 co = {c01[0], c01[2], c23[0], c23[2]}, si = {c01[1], c01[3], c23[1], c23[3]};
                        o1[n] = x1 * co - x2 * si; o2[n] = x1 * si + x2 * co; }
                    bf16_t* qp = Q + (size_t)row * 1536 + (4 * (u.pn - 4) + wc) * 192 + 128 + 8 * fq;
                    *(u32x4*)qp = pk8(o1[0], o1[1]); *(u32x4*)(qp + 32) = pk8(o2[0], o2[1]); } }
    }
};

template <class Epi, class Sched, bool ALIGN_EPI = false, bool SP2 = false>
__device__ __forceinline__ void gemm_phase(PG8_LAS unsigned char* lds, const Gemm g, const Sched& S, const Epi& E) {
    int tid_ = threadIdx.x; asm volatile("" : "+v"(tid_));
    const int tid = tid_, wid = __builtin_amdgcn_readfirstlane(tid >> 6), lane = tid & 63, wr = wid >> 2, wc = wid & 3, fr = lane & 15, fq = lane >> 4;
    const int K = g.K, nt = K / BK;
    unsigned voffA[2], voffB[2];
#pragma unroll
    for (int i = 0; i < 2; ++i) { int R, C; stage_rc(tid * 16 + i * 8192, R, C); const int Rb = Epi::PERM ? ((R & ~31) + perm32(R & 31)) : R;
        voffA[i] = (unsigned)(R * K + C) * 2u; voffB[i] = (unsigned)(Rb * K + C) * 2u; }
    const size_t kstep = (size_t)(BK * 2);
    const size_t hstep = (size_t)HALF * K * 2;
    const size_t tstep = 2 * hstep;
    const unsigned ldsw = (unsigned)wid * 1024u;
    const int aoff = lds_byte(wr * 64 + fr, fq * 8), boff = lds_byte(wc * 32 + fr, fq * 8);
#define PG8_SA(b, h) (((b) * 2 + (h)) * HTB)
#define PG8_SB(b, h) ((4 + (b) * 2 + (h)) * HTB)
#define PG8_STAGE(bufoff, gbase, voff) do { _Pragma("unroll") for (int _i = 0; _i < 2; ++_i) \
        __builtin_amdgcn_global_load_lds((const unsigned*)((const char*)(gbase) + (voff)[_i]), (PG8_LAS unsigned*)(lds + (bufoff) + ldsw + _i * 8192), 16, 0, 0); } while (0)
#define PG8_LDA(dst, b, h) do { _Pragma("unroll") for (int m = 0; m < 4; ++m) _Pragma("unroll") for (int k = 0; k < 2; ++k) dst[m][k] = *(const PG8_LAS bf16x8*)(lds + PG8_SA(b, h) + aoff + m * 2048 + k * 1024); } while (0)
#define PG8_LDB(dst, b, h) do { _Pragma("unroll") for (int n = 0; n < 2; ++n) _Pragma("unroll") for (int k = 0; k < 2; ++k) dst[n][k] = *(const PG8_LAS bf16x8*)(lds + PG8_SB(b, h) + boff + n * 2048 + k * 1024); } while (0)
#define PG8_MMA(ai, bj, At, Bt) do { __builtin_amdgcn_s_setprio(1); _Pragma("unroll") for (int m = 0; m < 4; ++m) _Pragma("unroll") for (int n = 0; n < 2; ++n) _Pragma("unroll") for (int k = 0; k < 2; ++k) \
        acc[ai][bj][m][n] = __builtin_amdgcn_mfma_f32_16x16x32_bf16(Bt[n][k], At[m][k], acc[ai][bj][m][n], 0, 0, 0); __builtin_amdgcn_s_setprio(0); } while (0)
#define PG8_WAIT_V(n) asm volatile("s_waitcnt vmcnt(" #n ")" ::: "memory")
#define PG8_WAIT_L(n) asm volatile("s_waitcnt lgkmcnt(" #n ")" ::: "memory")
#define PG8_BAR __builtin_amdgcn_s_barrier()
#define PG8_SCHED __builtin_amdgcn_sched_barrier(0)
    Unit cur, nxt; int ui = 0;
    if (!S.next(0, cur)) return;
    f32x4 acc[2][2][4][2];
#pragma unroll
    for (int a = 0; a < 2; ++a)
#pragma unroll
        for (int b = 0; b < 2; ++b)
#pragma unroll
            for (int m = 0; m < 4; ++m)
#pragma unroll
                for (int n = 0; n < 2; ++n) acc[a][b][m][n] = (f32x4){0.f, 0.f, 0.f, 0.f};
    bf16x8 At[4][2], B0[2][2], B1[2][2];
    const char* cA = (const char*)g.A + (size_t)cur.pm * tstep; const char* cB = (const char*)g.Bt + (size_t)cur.pn * tstep;
    S.a_ready(cur);
    if constexpr (SP2) {
        PG8_STAGE(PG8_SB(0, 0), cB, voffB); PG8_STAGE(PG8_SB(0, 1), cB + hstep, voffB); PG8_STAGE(PG8_SA(0, 0), cA, voffA); PG8_STAGE(PG8_SA(0, 1), cA + hstep, voffA);
        if (wr == 1) PG8_BAR;
        PG8_WAIT_V(2); PG8_BAR;
        PG8_STAGE(PG8_SB(1, 0), cB + kstep, voffB); PG8_STAGE(PG8_SA(1, 0), cA + kstep, voffA); PG8_STAGE(PG8_SB(1, 1), cB + hstep + kstep, voffB);
        PG8_WAIT_V(6); PG8_BAR;
    } else {
        PG8_STAGE(PG8_SB(0, 0), cB, voffB); PG8_STAGE(PG8_SA(0, 0), cA, voffA); PG8_STAGE(PG8_SB(0, 1), cB + hstep, voffB); PG8_STAGE(PG8_SA(0, 1), cA + hstep, voffA);
        if (wr == 1) PG8_BAR;
        PG8_WAIT_V(4); PG8_BAR;
        PG8_STAGE(PG8_SB(1, 0), cB + kstep, voffB); PG8_STAGE(PG8_SA(1, 0), cA + kstep, voffA); PG8_STAGE(PG8_SB(1, 1), cB + hstep + kstep, voffB);
        PG8_WAIT_V(6); PG8_BAR;
    }
    for (;;) {
        const bool has_next = S.next(ui + 1, nxt);
        const char* nA = has_next ? (const char*)g.A + (size_t)nxt.pm * tstep : cA; const char* nB = has_next ? (const char*)g.Bt + (size_t)nxt.pn * tstep : cB;
        for (int t = 0; t < nt; t += 2) {
            const bool last = (t == nt - 2);
            const char* a1 = cA + (size_t)(t + 1) * kstep;
            const char* a2 = last ? nA : cA + (size_t)(t + 2) * kstep; const char* b2 = last ? nB : cB + (size_t)(t + 2) * kstep;
            const char* a3 = a2 + kstep; const char* b3 = b2 + kstep;
            if (last && has_next) S.a_ready(nxt);
            if constexpr (SP2) {
            PG8_LDB(B0, 0, 0); PG8_LDB(B1, 0, 1); PG8_SCHED; PG8_LDA(At, 0, 0); PG8_STAGE(PG8_SA(1, 1), a1 + hstep, voffA);
            PG8_WAIT_V(8); PG8_WAIT_L(0); PG8_BAR; PG8_MMA(0, 0, At, B0); PG8_MMA(0, 1, At, B1); PG8_BAR; PG8_SCHED;
            PG8_LDA(At, 0, 1); PG8_STAGE(PG8_SB(0, 0), b2, voffB); PG8_STAGE(PG8_SB(0, 1), b2 + hstep, voffB); PG8_STAGE(PG8_SA(0, 0), a2, voffA);
            PG8_WAIT_V(8); PG8_WAIT_L(0); PG8_BAR; PG8_MMA(1, 0, At, B0); PG8_MMA(1, 1, At, B1); PG8_BAR; PG8_SCHED;
            PG8_LDB(B0, 1, 0); PG8_LDB(B1, 1, 1); PG8_SCHED; PG8_LDA(At, 1, 0); PG8_STAGE(PG8_SA(0, 1), a2 + hstep, voffA);
            PG8_WAIT_V(8); PG8_WAIT_L(0); PG8_BAR; PG8_MMA(0, 0, At, B0); PG8_MMA(0, 1, At, B1); PG8_BAR; PG8_SCHED;
            PG8_LDA(At, 1, 1); PG8_STAGE(PG8_SB(1, 0), b3, voffB); PG8_STAGE(PG8_SB(1, 1), b3 + hstep, voffB); PG8_STAGE(PG8_SA(1, 0), a3, voffA);
            PG8_WAIT_V(8); PG8_WAIT_L(0); PG8_BAR; PG8_MMA(1, 0, At, B0); PG8_MMA(1, 1, At, B1); PG8_BAR; PG8_SCHED;
            } else {
            PG8_LDB(B0, 0, 0); PG8_SCHED; PG8_LDA(At, 0, 0); PG8_STAGE(PG8_SA(1, 1), a1 + hstep, voffA);
            PG8_WAIT_L(8); PG8_BAR; PG8_WAIT_L(0); PG8_MMA(0, 0, At, B0); PG8_BAR; PG8_SCHED;
            PG8_LDB(B1, 0, 1); PG8_STAGE(PG8_SB(0, 0), b2, voffB);
            PG8_BAR; PG8_WAIT_L(0); PG8_MMA(0, 1, At, B1); PG8_BAR;
            PG8_LDA(At, 0, 1); PG8_STAGE(PG8_SA(0, 0), a2, voffA);
            PG8_BAR; PG8_WAIT_L(0); PG8_MMA(1, 0, At, B0); PG8_BAR; PG8_SCHED;
            PG8_STAGE(PG8_SB(0, 1), b2 + hstep, voffB);
            PG8_WAIT_V(6); PG8_BAR; PG8_MMA(1, 1, At, B1); PG8_BAR;
            PG8_LDB(B0, 1, 0); PG8_SCHED; PG8_LDA(At, 1, 0); PG8_STAGE(PG8_SA(0, 1), a2 + hstep, voffA);
            PG8_WAIT_L(8); PG8_BAR; PG8_WAIT_L(0); PG8_MMA(0, 0, At, B0); PG8_BAR; PG8_SCHED;
            PG8_LDB(B1, 1, 1); PG8_STAGE(PG8_SB(1, 0), b3, voffB);
            PG8_BAR; PG8_WAIT_L(0); PG8_MMA(0, 1, At, B1); PG8_BAR;
            PG8_LDA(At, 1, 1); PG8_STAGE(PG8_SA(1, 0), a3, voffA);
            PG8_BAR; PG8_WAIT_L(0); PG8_MMA(1, 0, At, B0); PG8_BAR; PG8_SCHED;
            PG8_STAGE(PG8_SB(1, 1), b3 + hstep, voffB);
            PG8_WAIT_V(6); PG8_BAR; PG8_MMA(1, 1, At, B1); PG8_BAR;
            }
        }
        if constexpr (ALIGN_EPI) { if (wr == 0) PG8_BAR; }
        if constexpr (!Epi::AFTER_DRAIN) { E(acc, cur, wr, wc, fr, fq); S.done(cur); }
        if (!has_next) break;
#pragma unroll
        for (int a = 0; a < 2; ++a)
#pragma unroll
            for (int b = 0; b < 2; ++b)
#pragma unroll
                for (int m = 0; m < 4; ++m)
#pragma unroll
                    for (int n = 0; n < 2; ++n) acc[a][b][m][n] = (f32x4){0.f, 0.f, 0.f, 0.f};
        cur = nxt; cA = nA; cB = nB; ++ui;
        if constexpr (ALIGN_EPI) { if (wr == 1) PG8_BAR; }
    }
    PG8_WAIT_V(0);
    if constexpr (!ALIGN_EPI) { if (wr == 0) PG8_BAR; }
    PG8_BAR;
    if constexpr (Epi::AFTER_DRAIN) { E.fused(acc, cur, wr, wc, fr, fq, lds, wid, lane); S.done(cur); }
#undef PG8_SA
#undef PG8_SB
#undef PG8_STAGE
#undef PG8_LDA
#undef PG8_LDB
#undef PG8_MMA
#undef PG8_WAIT_V
#undef PG8_WAIT_L
#undef PG8_BAR
#undef PG8_SCHED
}}

#define LAS __attribute__((address_space(3)))
typedef unsigned short bf16_t;
typedef short bf16x8 __attribute__((ext_vector_type(8)));
typedef float f32x4 __attribute__((ext_vector_type(4)));
typedef float f32x16 __attribute__((ext_vector_type(16)));
typedef unsigned u32x4 __attribute__((ext_vector_type(4)));
typedef unsigned u32x2 __attribute__((ext_vector_type(2)));
using pg8::pk_bf16; using pg8::pk8;

namespace att {
constexpr int KROW = 400, KTILE = 64 * KROW, VROW = 144, VTILE = 128 * VROW, BUF = KTILE + VTILE;
__device__ __forceinline__ int crow(int r, int hi) { return (r & 3) + 8 * (r >> 2) + 4 * hi; }
#define ATT_MFMA(a, b, c) __builtin_amdgcn_mfma_f32_32x32x16_bf16((a), (b), (c), 0, 0, 0)
#define ATT_SB() __builtin_amdgcn_sched_barrier(0)
__device__ __forceinline__ float max3f(float a, float b, float c) { float r; asm("v_max3_f32 %0, %1, %2, %3" : "=v"(r) : "v"(a), "v"(b), "v"(c)); return r; }
__device__ __forceinline__ void attn_unit(int b, int h, int qb, const bf16_t* __restrict__ Q, const bf16_t* __restrict__ KN, const bf16_t* __restrict__ KPE, const bf16_t* __restrict__ VT, bf16_t* __restrict__ O, LAS unsigned char* lds) {
    int tid_ = threadIdx.x; asm volatile("" : "+v"(tid_));
    const int tid = tid_, lane = tid & 63, wid = __builtin_amdgcn_readfirstlane(tid >> 6), q32 = lane & 31, hi = lane >> 5;
    const int q0 = qb * 256; const size_t tok0 = (size_t)b * SEQ;
    const int qrow = q0 + wid * 32 + q32;
    bf16x8 qf[12];
    { const bf16_t* qp = Q + (tok0 + qrow) * 1536 + h * 192 + hi * 8;
#pragma unroll
      for (int s = 0; s < 12; ++s) qf[s] = *(const bf16x8*)(qp + s * 16); }
    const char* kbase = (const char*)(KN + tok0 * 1024 + h * 128); const char* pbase = (const char*)(KPE + tok0 * 64); const char* vbase = (const char*)(VT + (size_t)(b * 8 + h) * 128 * 2048);
#define ATT_RETID() int t2_ = tid; asm volatile("" : "+v"(t2_)); const unsigned srow_ = (unsigned)t2_ >> 3, spart_ = (unsigned)t2_ & 7u
    const int NT = (q0 + 256) / 64;
    u32x4 rb0, rb1, rb2, rb3, rb4;
#define ATT_LOAD(t, R0, R1, R2, R3, R4) do { ATT_RETID(); const unsigned koff = srow_ * 2048 + spart_ * 16, poff = srow_ * 128 + spart_ * 16, voff = srow_ * 4096 + spart_ * 16; \
        const char* kb_ = kbase + (size_t)(t) * (64 * 2048); const char* pb_ = pbase + (size_t)(t) * (64 * 128); const char* vb_ = vbase + (size_t)(t) * 128; \
        R0 = *(const u32x4*)(kb_ + koff); R1 = *(const u32x4*)(kb_ + 128 + koff); R2 = *(const u32x4*)(pb_ + poff); R3 = *(const u32x4*)(vb_ + voff); R4 = *(const u32x4*)(vb_ + 64 * 4096 + voff); } while (0)
#define ATT_STORE(bo, R0, R1, R2, R3, R4) do { ATT_RETID(); const unsigned kdst = srow_ * KROW + spart_ * 16, vdst = KTILE + srow_ * VROW + (spart_ >> 1) * 32 + (spart_ & 1) * 8; LAS unsigned char* b_ = lds + (bo); \
        *(LAS u32x4*)(b_ + kdst) = R0; *(LAS u32x4*)(b_ + kdst + 128) = R1; *(LAS u32x4*)(b_ + kdst + 256) = R2; \
        *(LAS u32x2*)(b_ + vdst) = (u32x2){R3.x, R3.y}; *(LAS u32x2*)(b_ + vdst + 16) = (u32x2){R3.z, R3.w}; \
        *(LAS u32x2*)(b_ + vdst + 64 * VROW) = (u32x2){R4.x, R4.y}; *(LAS u32x2*)(b_ + vdst + 64 * VROW + 16) = (u32x2){R4.z, R4.w}; } while (0)
#define ATT_LOAD_B(t) ATT_LOAD(t, rb0, rb1, rb2, rb3, rb4)
#define ATT_STORE_B(bo) ATT_STORE(bo, rb0, rb1, rb2, rb3, rb4)
    f32x16 o[4];
#pragma unroll
    for (int d = 0; d < 4; ++d)
#pragma unroll
        for (int r = 0; r < 16; ++r) o[d][r] = 0.f;
    float mrun = 0.f, lrun = 0.f;
    f32x16 negm;
#pragma unroll
    for (int r = 0; r < 16; ++r) negm[r] = 0.f;
    ATT_LOAD_B(0); ATT_STORE_B(0); __syncthreads();
#define ATT_COMPUTE(t_) do { const int t = (t_); const int cur = (t & 1) * BUF, k0 = t * 64; \
        if (k0 <= q0 + wid * 32 + 31) { \
            f32x16 s0 = negm, s1 = negm; \
            const LAS unsigned char* kb = lds + cur + q32 * KROW + hi * 16; \
            bf16x8 ka[2][2]; \
            ATT_SB(); \
        _Pragma("unroll") \
            for (int st = 0; st < 2; ++st) { ka[st][0] = *(const LAS bf16x8*)(kb + st * 32); ka[st][1] = *(const LAS bf16x8*)(kb + 32 * KROW + st * 32); } \
            ATT_SB(); \
        _Pragma("unroll") \
            for (int st = 0; st < 12; ++st) { \
                s0 = ATT_MFMA(ka[st & 1][0], qf[st], s0); s1 = ATT_MFMA(ka[st & 1][1], qf[st], s1); \
                ATT_SB(); \
                if (st + 2 < 12) { ka[st & 1][0] = *(const LAS bf16x8*)(kb + (st + 2) * 32); ka[st & 1][1] = *(const LAS bf16x8*)(kb + 32 * KROW + (st + 2) * 32); ATT_SB(); } \
            } \
            asm volatile("s_nop 15\n\ts_nop 7" : "+v"(s0), "+v"(s1));     \
            if (k0 + 63 > q0 + wid * 32) { \
        _Pragma("unroll") \
                for (int r = 0; r < 16; ++r) { const int key = k0 + crow(r, hi); if (key > qrow) s0[r] = -INFINITY; if (key + 32 > qrow) s1[r] = -INFINITY; } \
            } \
            float mxa = max3f(s0[0], s0[1], s1[0]), mxb = max3f(s0[2], s0[3], s1[1]); mxa = max3f(mxa, s1[2], s1[3]); \
        _Pragma("unroll") \
            for (int r = 4; r < 16; r += 4) { mxa = max3f(mxa, s0[r], s0[r + 1]); mxb = max3f(mxb, s0[r + 2], s0[r + 3]); mxa = max3f(mxa, s1[r], s1[r + 1]); mxb = max3f(mxb, s1[r + 2], s1[r + 3]); } \
            float mx = max3f(mxa, mxb, mxb); \
            { auto rr = __builtin_amdgcn_permlane32_swap(__float_as_uint(mx), __float_as_uint(mx), false, false); mx = max3f(__uint_as_float(rr[0]), __uint_as_float(rr[1]), mx); } \
            if (t == 0 || __any(mx > 8.0f)) {        \
                const float dl = (t == 0) ? mx : fmaxf(mx, 0.f), alpha = (t == 0) ? 1.0f : __builtin_amdgcn_exp2f(-dl); mrun += dl; lrun *= alpha; \
        _Pragma("unroll") \
                for (int r = 0; r < 16; ++r) { s0[r] -= dl; s1[r] -= dl; negm[r] = -mrun; } \
        _Pragma("unroll") \
                for (int d = 0; d < 4; ++d) \
        _Pragma("unroll") \
                    for (int r = 0; r < 16; ++r) o[d][r] *= alpha; } \
            const LAS unsigned char* vb = lds + cur + KTILE + q32 * VROW + hi * 16; \
            bf16x8 va[2][4]; \
            ATT_SB(); \
        _Pragma("unroll") \
            for (int d = 0; d < 4; ++d) va[0][d] = *(const LAS bf16x8*)(vb + d * 32 * VROW); \
            ATT_SB(); \
              \
        _Pragma("unroll") \
            for (int r = 0; r < 16; ++r) s0[r] = __builtin_amdgcn_exp2f(s0[r]); \
            bf16x8 pk[4]; \
            { u32x4 w; \
              w.x = pk_bf16(s0[0], s0[1]); w.y = pk_bf16(s0[2], s0[3]); w.z = pk_bf16(s0[4], s0[5]); w.w = pk_bf16(s0[6], s0[7]); pk[0] = __builtin_bit_cast(bf16x8, w); \
              w.x = pk_bf16(s0[8], s0[9]); w.y = pk_bf16(s0[10], s0[11]); w.z = pk_bf16(s0[12], s0[13]); w.w = pk_bf16(s0[14], s0[15]); pk[1] = __builtin_bit_cast(bf16x8, w); } \
            ATT_SB(); \
        _Pragma("unroll") \
            for (int j = 0; j < 2; ++j) { \
        _Pragma("unroll") \
                for (int d = 0; d < 4; ++d) { \
                    va[(j + 1) & 1][d] = *(const LAS bf16x8*)(vb + d * 32 * VROW + (j + 1) * 32); \
                    o[d] = ATT_MFMA(va[j & 1][d], pk[j], o[d]); \
                    s1[(j * 4 + d) * 2] = __builtin_amdgcn_exp2f(s1[(j * 4 + d) * 2]); s1[(j * 4 + d) * 2 + 1] = __builtin_amdgcn_exp2f(s1[(j * 4 + d) * 2 + 1]); \
                    ATT_SB(); } } \
            { u32x4 w; \
              w.x = pk_bf16(s1[0], s1[1]); w.y = pk_bf16(s1[2], s1[3]); w.z = pk_bf16(s1[4], s1[5]); w.w = pk_bf16(s1[6], s1[7]); pk[2] = __builtin_bit_cast(bf16x8, w); \
              w.x = pk_bf16(s1[8], s1[9]); w.y = pk_bf16(s1[10], s1[11]); w.z = pk_bf16(s1[12], s1[13]); w.w = pk_bf16(s1[14], s1[15]); pk[3] = __builtin_bit_cast(bf16x8, w); } \
            ATT_SB(); \
            float ls = 0.f; \
        _Pragma("unroll") \
            for (int j = 2; j < 4; ++j) { \
        _Pragma("unroll") \
                for (int d = 0; d < 4; ++d) { \
                    if (j + 1 < 4) va[(j + 1) & 1][d] = *(const LAS bf16x8*)(vb + d * 32 * VROW + (j + 1) * 32); \
                    o[d] = ATT_MFMA(va[j & 1][d], pk[j], o[d]); \
                    { const int q4 = ((j - 2) * 4 + d) * 2; ls += (s0[q4] + s0[q4 + 1]) + (s1[q4] + s1[q4 + 1]); } \
                    ATT_SB(); } } \
            lrun += ls; \
        } \
    } while (0)
    for (int tt = 0; tt < NT; tt += 2) {
        ATT_LOAD_B(tt + 1);
        ATT_COMPUTE(tt);
        ATT_STORE_B(BUF);
        __syncthreads();
        ATT_LOAD_B(tt + 2 < NT ? tt + 2 : NT - 1);
        ATT_COMPUTE(tt + 1);
        if (tt + 2 < NT) ATT_STORE_B(0);
        __syncthreads();
    }
#undef ATT_COMPUTE
    const float ltot = lrun + __shfl_xor(lrun, 32), inv = 1.0f / ltot;
    bf16_t* op = O + (tok0 + qrow) * 1024 + h * 128 + 8 * hi;
#pragma unroll
    for (int d = 0; d < 4; ++d)
#pragma unroll
        for (int k = 0; k < 2; ++k) { const int g0 = 2 * k, g1 = 2 * k + 1;
            unsigned a0 = pk_bf16(o[d][4 * g0] * inv, o[d][4 * g0 + 1] * inv), a1 = pk_bf16(o[d][4 * g0 + 2] * inv, o[d][4 * g0 + 3] * inv);
            unsigned b0 = pk_bf16(o[d][4 * g1] * inv, o[d][4 * g1 + 1] * inv), b1 = pk_bf16(o[d][4 * g1 + 2] * inv, o[d][4 * g1 + 3] * inv);
            auto r0 = __builtin_amdgcn_permlane32_swap(a0, b0, false, false); auto r1 = __builtin_amdgcn_permlane32_swap(a1, b1, false, false);
            u32x4 w; w.x = r0[0]; w.y = r1[0]; w.z = r0[1]; w.w = r1[1];
            *(u32x4*)(op + d * 32 + k * 16) = w; }
#undef ATT_LOAD
#undef ATT_STORE
#undef ATT_RETID
#undef ATT_LOAD_B
#undef ATT_STORE_B
}
__device__ __forceinline__ void attn_phase(const bf16_t* Q, const bf16_t* KN, const bf16_t* KPE, const bf16_t* VT, bf16_t* O, LAS unsigned char* lds) {
    const int G = gridDim.x, bx = blockIdx.x, vcu = (G % 8 == 0) ? (bx % 8) * (G / 8) + bx / 8 : bx;
    for (int p = vcu; p < 512; p += G) { const int bh = p >> 2, s = p & 3;
        attn_unit(bh >> 3, bh & 7, 7 - s, Q, KN, KPE, VT, O, lds);
        attn_unit(bh >> 3, bh & 7, s, Q, KN, KPE, VT, O, lds); }
}
}

typedef unsigned v4u __attribute__((ext_vector_type(4)));
#define XB_TMO      128
#define XB_XCNT(j)  (256  + 64 * (j))
#define XB_XSUB(j)  (1280 + 64 * (j))
#define XB_XGEN(j)  (2304 + 64 * (j))
#define XB_TOP      3328
#define XB_TOPGEN   3392
#define XCD_BAR_WORDS 3456
#define XB_SPIN_CAP (1u << 18)

__device__ __forceinline__ unsigned xb_ld(unsigned* p)              { return __hip_atomic_load(p, __ATOMIC_RELAXED, __HIP_MEMORY_SCOPE_AGENT); }
__device__ __forceinline__ unsigned xb_add(unsigned* p, unsigned v) { return __hip_atomic_fetch_add(p, v, __ATOMIC_RELAXED, __HIP_MEMORY_SCOPE_AGENT); }
__device__ __forceinline__ unsigned xb_xcc_id() { return (unsigned)__builtin_amdgcn_s_getreg((3 << 11) | 20) & 0xFu; }
#define XB_SPIN(cond, bar) do { unsigned _sp = 0; while (cond) { __builtin_amdgcn_s_sleep(1); \
    if ((++_sp & 255u) == 0u) { if (xb_ld(&(bar)[XB_TMO])) break; if (_sp > XB_SPIN_CAP) { atomicAdd(&(bar)[XB_TMO], 1u); break; } } } } while (0)

struct XcdBarrier {
    unsigned* bar; unsigned x;
    volatile LAS unsigned* st;
};

__device__ __forceinline__ XcdBarrier xcd_barrier_post(unsigned* bar, volatile LAS unsigned* st) {
    XcdBarrier b; b.bar = bar; b.x = xb_xcc_id(); b.st = st;
    if (threadIdx.x == 0) (void)xb_add(&bar[XB_XCNT(b.x)], 1u);
    return b;
}
__device__ __forceinline__ void xcd_barrier_complete(unsigned* bar, unsigned x, unsigned& nloc, unsigned& nx) {
    const unsigned G = gridDim.x * gridDim.y * gridDim.z;
    unsigned sum, cnt, mine, sp = 0u;
    for (;;) {
        sum = 0u; cnt = 0u; mine = 0u;
#pragma unroll
        for (unsigned j = 0; j < 16; ++j) { const unsigned c = xb_ld(&bar[XB_XCNT(j)]); sum += c; cnt += (c > 0u) ? 1u : 0u; mine = (j == x) ? c : mine; }
        if (sum == G) break;
        __builtin_amdgcn_s_sleep(1);
        if ((++sp & 255u) == 0u) { if (xb_ld(&bar[XB_TMO])) break; if (sp > XB_SPIN_CAP) { atomicAdd(&bar[XB_TMO], 1u); break; } }
    }
    nloc = mine > 0u ? mine : 1u; nx = cnt > 0u ? cnt : 1u;
}

__device__ __forceinline__ void xcd_barrier(const XcdBarrier& b) {
    asm volatile("s_waitcnt vmcnt(0)" ::: "memory");
    __syncthreads();
    if (threadIdx.x == 0) {
        unsigned* bar = b.bar;
        __builtin_amdgcn_s_waitcnt(0);
        unsigned nloc = b.st[0], nx = b.st[1];
        if (nloc == 0u) { xcd_barrier_complete(bar, b.x, nloc, nx); b.st[0] = nloc; b.st[1] = nx; }
        const unsigned old = xb_add(&bar[XB_XSUB(b.x)], 1u);
        const unsigned gen = old / nloc;
        if (old + 1u == (gen + 1u) * nloc) {
            __builtin_amdgcn_fence(__ATOMIC_RELEASE, "agent");
            asm volatile("s_waitcnt vmcnt(0)" ::: "memory");
            const unsigned og = xb_add(&bar[XB_TOP], 1u);
            const unsigned tg = og / nx;
            if (og + 1u == (tg + 1u) * nx) xb_add(&bar[XB_TOPGEN], 1u);
            else XB_SPIN(xb_ld(&bar[XB_TOPGEN]) == tg, bar);
            __builtin_amdgcn_fence(__ATOMIC_ACQUIRE, "agent");
            xb_add(&bar[XB_XGEN(b.x)], 1u);
            asm volatile("s_waitcnt vmcnt(0)" ::: "memory");
        } else {
            XB_SPIN(xb_ld(&bar[XB_XGEN(b.x)]) == gen, bar);
            __builtin_amdgcn_fence(__ATOMIC_ACQUIRE, "agent");
            asm volatile("s_waitcnt vmcnt(0)" ::: "memory");
        }
    }
    __syncthreads();
}

constexpr size_t MiB = 1u << 20;
constexpr size_t WS_BAR = 2 * MiB + 512 * 1024, BAR_BYTES = 16384;
constexpr size_t WS_SSQH = 0, WS_SSQL = 2 * MiB, WS_SSQQ = 3 * MiB, WS_CS = 4 * MiB, WS_HB = 12 * MiB, WS_W = 76 * MiB;
constexpr size_t SZ_WIN = (size_t)3072 * 1024 * 2, SZ_WSQ = (size_t)1024 * 1024 * 2, SZ_W13 = (size_t)5632 * 1024 * 2, SZ_W2 = (size_t)1024 * 2816 * 2;
constexpr size_t OW_WIN = 0, OW_WOUT = SZ_WIN, OW_CW13 = SZ_WIN + SZ_WSQ, OW_CW2 = OW_CW13 + SZ_W13, SZ_CONV = OW_CW2 + SZ_W2;
constexpr size_t OW_DKVQ = 2 * SZ_CONV, OW_WK = OW_DKVQ + SZ_WSQ, SZ_WK = (size_t)1024 * 256 * 2, OW_WVT = OW_WK + SZ_WK;
constexpr size_t OW_WUQ = OW_WVT + SZ_WK, SZ_WUQ = (size_t)1536 * 384 * 2, OW_WDQ1 = OW_WUQ + 2 * SZ_WUQ, SZ_WDQ1 = (size_t)512 * 1024 * 2;
constexpr size_t OW_WO = OW_WDQ1 + SZ_WDQ1, OW_MW13 = OW_WO + 2 * SZ_WSQ, OW_MW2 = OW_MW13 + 2 * SZ_W13, SZ_WALL = OW_MW2 + 2 * SZ_W2;
static_assert(SZ_WALL <= 93 * MiB, "weights");
constexpr size_t WS_KN = 169 * MiB, WS_VT = 233 * MiB, WS_KPE = 297 * MiB, WS_ACT = 301 * MiB, WS_END = 477 * MiB;
constexpr size_t WS_Z = WS_KN, WS_GB = WS_VT, WS_Y = WS_ACT;
constexpr size_t WS_Q = WS_ACT, WS_ATT = WS_ACT + 96 * MiB, WS_CLAT = WS_ACT + 96 * MiB, WS_CQ = WS_ACT + 112 * MiB;

constexpr int LDS_BYTES = 140288;

struct Params { const float* in[22]; float* out; unsigned char* ws; };

__device__ __forceinline__ float wave_sum(float v) {
#pragma unroll
    for (int o = 1; o < 64; o <<= 1) v += __shfl_xor(v, o);
    return v;
}
template <int MAP> __device__ __forceinline__ int map_src(int n0) {
    if (MAP == 0) return n0;
    if (MAP == 1) { if (n0 < 2048) { const int pn = n0 >> 8, bj = (n0 >> 7) & 1, i = n0 & 127; return 1024 + 1024 * bj + 128 * pn + i; } return n0 - 2048; }
    if (MAP == 2) { const int pn = n0 >> 8, bj = (n0 >> 7) & 1, i = n0 & 127; return bj * 2816 + 128 * pn + i; }
    if (MAP == 3) { if (n0 < 256) return n0; const int i = n0 - 256, bj = i >> 7, ii = i & 127; return ii == 0 ? 256 + 32 * bj : -1; }
    if (MAP == 4) return n0 < 384 ? n0 : -1;
    if (MAP == 5) { const int hh = n0 >> 7, i = n0 & 127; return 256 * hh + i; }
    if (MAP == 6) { const int hh = n0 >> 7, i = n0 & 127; return 256 * hh + 128 + i; }
    if (MAP == 7) { if (n0 < 1024) { const int hh = n0 >> 7, i = n0 & 127; return 192 * hh + i; }
                    const int q = n0 - 1024, pnr = q >> 8, bj = (q >> 7) & 1, i = q & 127, hh = 4 * pnr + (i >> 5); return 192 * hh + 128 + 32 * bj; }
    return n0;
}
template <int MAP> __device__ __forceinline__ void transpose_item(const float* __restrict__ W, int K, int Ns, int Nd, const float* __restrict__ gain, bf16_t* __restrict__ WT, LAS float* scr, int item, int lane) {
    const int nblk = Nd / 32, kb = item / nblk, nb = item - kb * nblk, k0 = 64 * kb, n0 = 32 * nb;
    const int src = map_src<MAP>(n0);
    float v[32];
    if (src >= 0) { const float* wp = W + (size_t)(k0 + (lane >> 5)) * Ns + src + (lane & 31);
#pragma unroll
        for (int i = 0; i < 32; ++i) v[i] = __builtin_nontemporal_load(wp + (size_t)(2 * i) * Ns);
    } else {
#pragma unroll
        for (int i = 0; i < 32; ++i) v[i] = 0.f; }
    const int c = lane & 7;
    f32x4 g0 = {1.f, 1.f, 1.f, 1.f}, g1 = g0;
    if (gain) { g0 = *(const f32x4*)(gain + k0 + 8 * c); g1 = *(const f32x4*)(gain + k0 + 8 * c + 4); }
#pragma unroll
    for (int i = 0; i < 32; ++i) scr[(2 * i + (lane >> 5)) * 33 + (lane & 31)] = v[i];
    asm volatile("s_waitcnt lgkmcnt(0)" ::: "memory");
#pragma unroll
    for (int j = 0; j < 4; ++j) { const int n = (lane >> 3) + 8 * j; const LAS float* s = scr + (8 * c) * 33 + n;
        u32x4 o; o.x = pk_bf16(s[0 * 33] * g0[0], s[1 * 33] * g0[1]); o.y = pk_bf16(s[2 * 33] * g0[2], s[3 * 33] * g0[3]); o.z = pk_bf16(s[4 * 33] * g1[0], s[5 * 33] * g1[1]); o.w = pk_bf16(s[6 * 33] * g1[2], s[7 * 33] * g1[3]);
        *(u32x4*)(WT + (size_t)(n0 + n) * K + k0 + 8 * c) = o; }
    asm volatile("s_waitcnt lgkmcnt(0)" ::: "memory");
}

__device__ __forceinline__ void prologue(const Params& p, LAS unsigned char* lds) {
    int tid_ = threadIdx.x; asm volatile("" : "+v"(tid_));
    const int tid = tid_, lane = tid & 63, wave = __builtin_amdgcn_readfirstlane(tid >> 6);
    const int gw = blockIdx.x * 8 + wave, NGW = gridDim.x * 8;
    LAS float* scr = (LAS float*)(lds + wave * 16384);
    unsigned char* ws = p.ws; bf16_t* wb = (bf16_t*)(ws + WS_W);
    constexpr int I_WIN = 16 * 96, I_SQ = 16 * 32, I_W13 = 16 * 176, I_W2 = 44 * 32, I_DKV = 16 * 16, I_DQ = 16 * 16, I_WK = 4 * 32, I_WUQ = 6 * 48;
#define BFW(off) ((bf16_t*)((unsigned char*)wb + (off)))
    int base = 0;
#define JOB(MAP, W, K, Ns, Nd, G, DST, CNT) do { for (int it = (gw + NGW - base % NGW) % NGW; it < (CNT); it += NGW) transpose_item<MAP>((W), (K), (Ns), (Nd), (G), (DST), scr, it, lane); base += (CNT); } while (0)
    for (int l = 0; l < 2; ++l) {
        JOB(1, p.in[3] + (size_t)l * 1024 * 3072, 1024, 3072, 3072, p.in[2] + l * 1024, BFW(l * SZ_CONV + OW_WIN), I_WIN);
        JOB(0, p.in[5] + (size_t)l * 1024 * 1024, 1024, 1024, 1024, (const float*)nullptr, BFW(l * SZ_CONV + OW_WOUT), I_SQ);
        JOB(2, p.in[7] + (size_t)l * 1024 * 5632, 1024, 5632, 5632, p.in[6] + l * 1024, BFW(l * SZ_CONV + OW_CW13), I_W13);
        JOB(0, p.in[8] + (size_t)l * 2816 * 1024, 2816, 1024, 1024, (const float*)nullptr, BFW(l * SZ_CONV + OW_CW2), I_W2);
    }
    JOB(3, p.in[10], 1024, 320, 512, p.in[9], BFW(OW_DKVQ), I_DKV);
    JOB(4, p.in[14], 1024, 384, 512, p.in[13], BFW(OW_DKVQ + (size_t)512 * 1024 * 2), I_DQ);
    JOB(5, p.in[12], 256, 2048, 1024, p.in[11], BFW(OW_WK), I_WK);
    JOB(6, p.in[12], 256, 2048, 1024, p.in[11], BFW(OW_WVT), I_WK);
    JOB(4, p.in[14] + (size_t)1024 * 384, 1024, 384, 512, p.in[13] + 1024, BFW(OW_WDQ1), I_DQ);
    for (int j = 0; j < 2; ++j) {
        JOB(7, p.in[16] + (size_t)j * 384 * 1536, 384, 1536, 1536, p.in[15] + j * 384, BFW(OW_WUQ + j * SZ_WUQ), I_WUQ);
        JOB(0, p.in[17] + (size_t)j * 1024 * 1024, 1024, 1024, 1024, (const float*)nullptr, BFW(OW_WO + j * SZ_WSQ), I_SQ);
        JOB(2, p.in[19] + (size_t)j * 1024 * 5632, 1024, 5632, 5632, p.in[18] + j * 1024, BFW(OW_MW13 + j * SZ_W13), I_W13);
        JOB(0, p.in[20] + (size_t)j * 2816 * 1024, 2816, 1024, 1024, (const float*)nullptr, BFW(OW_MW2 + j * SZ_W2), I_W2);
    }
#undef JOB
#undef BFW
    { const float* x = p.in[0]; bf16_t* HB = (bf16_t*)(ws + WS_HB); float* ssq = (float*)(ws + WS_SSQH);
      for (int row0 = gw * 4; row0 < T_; row0 += NGW * 4) { f32x4 v[4][4];
#pragma unroll
          for (int r = 0; r < 4; ++r)
#pragma unroll
              for (int j = 0; j < 4; ++j) v[r][j] = __builtin_nontemporal_load((const f32x4*)(x + (size_t)(row0 + r) * 1024) + lane + 64 * j);
#pragma unroll
          for (int r = 0; r < 4; ++r) { float s = 0.f;
#pragma unroll
              for (int j = 0; j < 4; ++j) { s += pg8::dot4(v[r][j]); u32x2 w; w.x = pk_bf16(v[r][j][0], v[r][j][1]); w.y = pk_bf16(v[r][j][2], v[r][j][3]); *((u32x2*)(HB + (size_t)(row0 + r) * 1024) + lane + 64 * j) = w; }
              s = wave_sum(s); if (lane < 16) ssq[(size_t)(row0 + r) * 16 + lane] = lane == 0 ? s : 0.f; } } }
    { const int* pos = (const int*)p.in[1]; float* CS = (float*)(ws + WS_CS);
      for (int idx = blockIdx.x * 512 + tid; idx < T_ * 32; idx += gridDim.x * 512) { const int row = idx >> 5, j = idx & 31;
          double f = 1.0; for (int i = 0; i < j; ++i) f *= 0.74989420933245582730;
          const float ang = (float)pos[row] * (float)f;
          const double xr = (double)ang * 0.15915494309189533577; const float fr = (float)(xr - __builtin_rint(xr));
          CS[(size_t)idx * 2] = __builtin_amdgcn_cosf(fr); CS[(size_t)idx * 2 + 1] = __builtin_amdgcn_sinf(fr); } }
}

__device__ __forceinline__ void bf8_to_f32(const u32x4 v, float* f) {
#pragma unroll
    for (int i = 0; i < 4; ++i) { f[2 * i] = __uint_as_float(v[i] << 16); f[2 * i + 1] = __uint_as_float(v[i] & 0xffff0000u); }
}
__device__ __forceinline__ void conv_phase(const bf16_t* __restrict__ Z, const bf16_t* __restrict__ GB, const float* __restrict__ cw, bf16_t* __restrict__ Y) {
    int tid_ = threadIdx.x; asm volatile("" : "+v"(tid_));
    const int tid = tid_, c8 = (tid & 127) * 8, rg = tid >> 7;
    f32x4 w0a = *(const f32x4*)(cw + c8), w0b = *(const f32x4*)(cw + c8 + 4), w1a = *(const f32x4*)(cw + 1024 + c8), w1b = *(const f32x4*)(cw + 1024 + c8 + 4), w2a = *(const f32x4*)(cw + 2048 + c8), w2b = *(const f32x4*)(cw + 2048 + c8 + 4);
    for (int ch = blockIdx.x; ch < T_ / 64; ch += gridDim.x) { const int row0 = ch * 64 + rg * 16;
        f32x4 m2a = {0.f, 0.f, 0.f, 0.f}, m2b = m2a, m1a = m2a, m1b = m2a;
        if ((row0 & (SEQ - 1)) != 0) { float f[8]; bf8_to_f32(*(const u32x4*)(Z + (size_t)(row0 - 2) * 1024 + c8), f); m2a = (f32x4){f[0], f[1], f[2], f[3]}; m2b = (f32x4){f[4], f[5], f[6], f[7]};
            bf8_to_f32(*(const u32x4*)(Z + (size_t)(row0 - 1) * 1024 + c8), f); m1a = (f32x4){f[0], f[1], f[2], f[3]}; m1b = (f32x4){f[4], f[5], f[6], f[7]}; }
#pragma unroll 4
        for (int i = 0; i < 16; ++i) { const size_t off = (size_t)(row0 + i) * 1024 + c8; float f[8], g[8];
            bf8_to_f32(*(const u32x4*)(Z + off), f); bf8_to_f32(*(const u32x4*)(GB + off), g);
            const f32x4 za = {f[0], f[1], f[2], f[3]}, zb = {f[4], f[5], f[6], f[7]}, ga = {g[0], g[1], g[2], g[3]}, gb = {g[4], g[5], g[6], g[7]};
            const f32x4 ya = ga * (w0a * m2a + w1a * m1a + w2a * za), yb = gb * (w0b * m2b + w1b * m1b + w2b * zb);
            *(u32x4*)(Y + off) = pk8(ya, yb); m2a = m1a; m2b = m1b; m1a = za; m1b = zb; }
    }
}
__device__ __forceinline__ void final_norm(float* out, const bf16_t* hb, const float* ssq, const float* g) {
    int tid_ = threadIdx.x; asm volatile("" : "+v"(tid_));
    const int tid = tid_, lane = tid & 63, wave = tid >> 6; const int gw = blockIdx.x * 8 + wave, NGW = gridDim.x * 8;
    f32x4 gv[2][2];
#pragma unroll
    for (int j = 0; j < 2; ++j) { const int c = (lane + 64 * j) * 8; gv[j][0] = *(const f32x4*)(g + c); gv[j][1] = *(const f32x4*)(g + c + 4); }
    for (int row0 = gw * 2; row0 < T_; row0 += NGW * 2) {
        float r[2]; u32x4 v[2][2];
#pragma unroll
        for (int k = 0; k < 2; ++k) { r[k] = pg8::rstd_of<16>(ssq, row0 + k, 1.0f / 1024.0f);
#pragma unroll
            for (int j = 0; j < 2; ++j) v[k][j] = *(const u32x4*)(hb + (size_t)(row0 + k) * 1024 + (lane + 64 * j) * 8); }
        asm volatile("" ::: "memory");
#pragma unroll
        for (int k = 0; k < 2; ++k)
#pragma unroll
            for (int j = 0; j < 2; ++j) { const int c = (lane + 64 * j) * 8; float f[8]; bf8_to_f32(v[k][j], f);
                *(f32x4*)(out + (size_t)(row0 + k) * 1024 + c) = (f32x4){f[0], f[1], f[2], f[3]} * r[k] * gv[j][0]; *(f32x4*)(out + (size_t)(row0 + k) * 1024 + c + 4) = (f32x4){f[4], f[5], f[6], f[7]} * r[k] * gv[j][1]; } }
}

__device__ __forceinline__ void conv_fix_rows(const bf16_t* __restrict__ Z, const bf16_t* __restrict__ GB, const float* __restrict__ cw, bf16_t* __restrict__ Y, int M, int N) {
    int tid_ = threadIdx.x; asm volatile("" : "+v"(tid_));
    const int tid = tid_;
    pg8::StaticOrder S; S.init(M, N, (int)gridDim.x, (int)blockIdx.x); pg8::Unit u;
    if (tid < 256) { const int r = tid >> 7, c8 = (tid & 127) * 8;
        const f32x4 w0a = *(const f32x4*)(cw + c8), w0b = *(const f32x4*)(cw + c8 + 4), w1a = *(const f32x4*)(cw + 1024 + c8), w1b = *(const f32x4*)(cw + 1024 + c8 + 4), w2a = *(const f32x4*)(cw + 2048 + c8), w2b = *(const f32x4*)(cw + 2048 + c8 + 4);
        for (int i = 0; S.next(i, u); ++i) { const int row = u.pm * 256 + r, t = row & (SEQ - 1); const size_t off = (size_t)row * 1024 + c8;
            f32x4 za, zb, ga, gb, z1a = {0.f, 0.f, 0.f, 0.f}, z1b = z1a, z2a = z1a, z2b = z1a;
            pg8::unpack8(*(const u32x4*)(Z + off), za, zb); pg8::unpack8(*(const u32x4*)(GB + off), ga, gb);
            if (t >= 1) pg8::unpack8(*(const u32x4*)(Z + off - 1024), z1a, z1b);
            if (t >= 2) pg8::unpack8(*(const u32x4*)(Z + off - 2048), z2a, z2b);
            *(u32x4*)(Y + off) = pk8(ga * (w0a * z2a + w1a * z1a + w2a * za), gb * (w0b * z2b + w1b * z1b + w2b * zb)); } }
    asm volatile("s_waitcnt vmcnt(0)" ::: "memory"); __syncthreads();
}

#define GEMM_PHASE(EPI, A_, B_, M_, N_, K_, E_) do { int k_ = (K_); asm volatile("" : "+s"(k_)); pg8::Gemm g_{(const bf16_t*)(A_), (const bf16_t*)(B_), (M_), (N_), k_}; pg8::StaticOrder S_; S_.init((M_), (N_), (int)gridDim.x, (int)blockIdx.x); \
        pg8::gemm_phase<EPI, pg8::StaticOrder, true, true>(lds, g_, S_, (E_)); } while (0)

typedef __attribute__((address_space(1))) unsigned char gbyte_t;
__device__ __forceinline__ unsigned char* fresh(unsigned char* q) { gbyte_t* g = (gbyte_t*)q; asm volatile("" : "+s"(g)); return (unsigned char*)g; }
#ifndef PH
#define PH 0xFFFF
#endif
#ifndef PROBE
#define PROBE 0
#endif
#define WSP(T, off) ((T*)(ws + (off)))
__global__ void __launch_bounds__(512, 2) yoco_fwd(Params p) {
    extern __shared__ __attribute__((aligned(16))) unsigned char lds_raw[];
    LAS unsigned char* lds = (LAS unsigned char*)lds_raw;
    cg::grid_group grid = cg::this_grid();
    volatile LAS unsigned* bst = (volatile LAS unsigned*)(lds + 131072);
    if (threadIdx.x < 2) bst[threadIdx.x] = 0u;
    __syncthreads();
    XcdBarrier xbar = xcd_barrier_post((unsigned*)(p.ws + WS_BAR), bst);
    if (PH & 1) prologue(p, lds);
    grid.sync();
    if (PROBE == 2) { prologue(p, lds); xcd_barrier(xbar); }
    if (PROBE == 3) { for (int i = 0; i < 20; ++i) xcd_barrier(xbar); }
    for (int l = 0; l < 2; ++l) {
        for (int rep = 0; rep < (PROBE == 5 ? 2 : 1); ++rep) {
        if (PH & 2) { unsigned char* ws = fresh(p.ws); int cpm_ = -1; pg8::EpiConvFused E{WSP(float, WS_SSQH), WSP(bf16_t, WS_Z), WSP(bf16_t, WS_GB), WSP(bf16_t, WS_Y), p.in[4] + l * 3 * 1024, (LAS float*)(lds + 132096), cpm_};
            int k_ = 1024; asm volatile("" : "+s"(k_)); pg8::Gemm g_{(const bf16_t*)(ws + WS_HB), (const bf16_t*)(ws + WS_W + l * SZ_CONV + OW_WIN), T_, 3072, k_}; pg8::TripleOrder S_; S_.init((int)gridDim.x, (int)blockIdx.x);
            pg8::gemm_phase<pg8::EpiConvFused, pg8::TripleOrder, true, true>(lds, g_, S_, E); }
        xcd_barrier(xbar);
        }
        if (PH & 8) { unsigned char* ws = fresh(p.ws); conv_fix_rows(WSP(bf16_t, WS_Z), WSP(bf16_t, WS_GB), p.in[4] + l * 3 * 1024, WSP(bf16_t, WS_Y), T_, 1024); if (l == 0) { pg8::EpiResid<true> E{p.in[0], WSP(bf16_t, WS_HB), WSP(float, WS_SSQH)}; GEMM_PHASE(pg8::EpiResid<true>, ws + WS_Y, ws + WS_W + l * SZ_CONV + OW_WOUT, T_, 1024, 1024, E); }
            else { pg8::EpiResid<false> E{nullptr, WSP(bf16_t, WS_HB), WSP(float, WS_SSQH)}; GEMM_PHASE(pg8::EpiResid<false>, ws + WS_Y, ws + WS_W + l * SZ_CONV + OW_WOUT, T_, 1024, 1024, E); } }
        xcd_barrier(xbar);
        for (int rep = 0; rep < (PROBE == 4 ? 2 : 1); ++rep) {
        if (PH & 16) { unsigned char* ws = fresh(p.ws); int cpm_ = -1; pg8::EpiSwiglu E{WSP(float, WS_SSQH), WSP(bf16_t, WS_ACT), (LAS float*)(lds + 132096), cpm_};
            GEMM_PHASE(pg8::EpiSwiglu, ws + WS_HB, ws + WS_W + l * SZ_CONV + OW_CW13, T_, 5632, 1024, E); }
        xcd_barrier(xbar);
        }
        if (PH & 8) { unsigned char* ws = fresh(p.ws); pg8::EpiResid<false> E{nullptr, WSP(bf16_t, WS_HB), WSP(float, WS_SSQH)};
            GEMM_PHASE(pg8::EpiResid<false>, ws + WS_ACT, ws + WS_W + l * SZ_CONV + OW_CW2, T_, 1024, 2816, E); }
        xcd_barrier(xbar);
    }
    for (int j = 0; j < 2; ++j) {
        if (PH & 32) { unsigned char* ws = fresh(p.ws); pg8::EpiDKVQ E{WSP(float, WS_SSQH), j == 0 ? 0 : 2, WSP(bf16_t, WS_CLAT), WSP(float, WS_SSQL), WSP(bf16_t, WS_KPE), WSP(float, WS_CS), WSP(bf16_t, WS_CQ), WSP(float, WS_SSQQ)};
            GEMM_PHASE(pg8::EpiDKVQ, ws + WS_HB, ws + WS_W + (j == 0 ? OW_DKVQ : OW_WDQ1), T_, (j == 0 ? 1024 : 512), 1024, E); }
        xcd_barrier(xbar);
        if (j == 0) {
            if (PH & 64) { unsigned char* ws = fresh(p.ws); pg8::EpiRowScale E{WSP(float, WS_SSQL), WSP(bf16_t, WS_KN)}; GEMM_PHASE(pg8::EpiRowScale, ws + WS_CLAT, ws + WS_W + OW_WK, T_, 1024, 256, E); }
            if (PH & 128) { unsigned char* ws = fresh(p.ws); pg8::EpiVT E{WSP(float, WS_SSQL), WSP(bf16_t, WS_VT)}; GEMM_PHASE(pg8::EpiVT, ws + WS_W + OW_WVT, ws + WS_CLAT, 1024, T_, 256, E); }
        }
        if (PH & 256) { unsigned char* ws = fresh(p.ws); pg8::EpiQ E{WSP(float, WS_SSQQ), WSP(float, WS_CS), WSP(bf16_t, WS_Q), QSCALE}; GEMM_PHASE(pg8::EpiQ, ws + WS_CQ, ws + WS_W + OW_WUQ + j * SZ_WUQ, T_, 1536, 384, E); }
        xcd_barrier(xbar);
        if (PROBE == 1) { unsigned char* ws = fresh(p.ws); att::attn_phase(WSP(bf16_t, WS_Q), WSP(bf16_t, WS_KN), WSP(bf16_t, WS_KPE), WSP(bf16_t, WS_VT), WSP(bf16_t, WS_ATT), lds); xcd_barrier(xbar); }
        if (PH & 512) { unsigned char* ws = fresh(p.ws); att::attn_phase(WSP(bf16_t, WS_Q), WSP(bf16_t, WS_KN), WSP(bf16_t, WS_KPE), WSP(bf16_t, WS_VT), WSP(bf16_t, WS_ATT), lds); }
        xcd_barrier(xbar);
        if (PH & 8) { unsigned char* ws = fresh(p.ws); pg8::EpiResid<false> E{nullptr, WSP(bf16_t, WS_HB), WSP(float, WS_SSQH)};
            GEMM_PHASE(pg8::EpiResid<false>, ws + WS_ATT, ws + WS_W + OW_WO + j * SZ_WSQ, T_, 1024, 1024, E); }
        xcd_barrier(xbar);
        if (PH & 16) { unsigned char* ws = fresh(p.ws); int cpm_ = -1; pg8::EpiSwiglu E{WSP(float, WS_SSQH), WSP(bf16_t, WS_ACT), (LAS float*)(lds + 132096), cpm_};
            GEMM_PHASE(pg8::EpiSwiglu, ws + WS_HB, ws + WS_W + OW_MW13 + j * SZ_W13, T_, 5632, 1024, E); }
        xcd_barrier(xbar);
        if (PH & 8) { unsigned char* ws = fresh(p.ws); pg8::EpiResid<false> E{nullptr, WSP(bf16_t, WS_HB), WSP(float, WS_SSQH)};
            GEMM_PHASE(pg8::EpiResid<false>, ws + WS_ACT, ws + WS_W + OW_MW2 + j * SZ_W2, T_, 1024, 2816, E); }
        xcd_barrier(xbar);
    }
    if (PH & 1024) { unsigned char* ws = fresh(p.ws); final_norm(p.out, WSP(bf16_t, WS_HB), WSP(float, WS_SSQH), p.in[21]); }
}

extern "C" void kernel_launch(void* const* d_in, const int* in_sizes, int n_in, void* d_out, int out_size, void* d_ws, size_t ws_size, hipStream_t stream) {
    static int grid = 0;
    if (grid == 0) {
        if (n_in != 22 || out_size != T_ * DM || ws_size < WS_END) { fprintf(stderr, "kernel_launch: unexpected shapes (n_in %d, out %d, ws %zu)\n", n_in, out_size, ws_size); grid = -1; return; }
        int dev = 0, cus = 0, per_cu = 0;
        (void)hipGetDevice(&dev); (void)hipDeviceGetAttribute(&cus, hipDeviceAttributeMultiprocessorCount, dev);
        if (hipFuncSetAttribute((const void*)yoco_fwd, hipFuncAttributeMaxDynamicSharedMemorySize, LDS_BYTES) != hipSuccess) { fprintf(stderr, "kernel_launch: hipFuncSetAttribute failed\n"); grid = -1; return; }
        if (hipOccupancyMaxActiveBlocksPerMultiprocessor(&per_cu, (const void*)yoco_fwd, 512, LDS_BYTES) != hipSuccess || per_cu < 1) { fprintf(stderr, "kernel_launch: occupancy query gave %d\n", per_cu); per_cu = 1; }
        (void)hipGetLastError();
        grid = cus * 1;
        if (grid <= 0) grid = 256;
    }
    if (grid < 0) return;
    if (hipMemsetAsync((char*)d_ws + WS_BAR, 0, BAR_BYTES, stream) != hipSuccess) { fprintf(stderr, "kernel_launch: memset of barrier words failed\n"); return; }
    Params p{};
    for (int i = 0; i < 22; ++i) p.in[i] = (const float*)d_in[i];
    p.out = (float*)d_out; p.ws = (unsigned char*)d_ws;
    void* args[] = {&p};
    hipError_t e = hipLaunchCooperativeKernel((const void*)yoco_fwd, dim3(grid), dim3(512), args, LDS_BYTES, stream);
    if (e != hipSuccess) fprintf(stderr, "kernel_launch: cooperative launch failed: %s (grid %d)\n", hipGetErrorString(e), grid);
}
```
